# Optimizing an MI355X kernel written in HIP

```python
import math
import jax, jax.numpy as jnp
from jax import lax
import numpy as np

D_MODEL = 1024
BATCH = 4
SEQ = 4096
DEPTH = 1

HEAD_DIM = 64
FOX_HEADS = 8
NSA_HEADS = 8
NSA_KV_GROUPS = 2
NSA_REP = NSA_HEADS // NSA_KV_GROUPS
CMP_BLOCK = 32
CMP_STRIDE = 16
CMP_HIDDEN = 256
SLC_BLOCK = 64
SLC_TOPK = 16
WINDOW = 512
Q_BLOCK = 128
REL_BUCKETS = 32
REL_MAX_DIST = 128
D_FF = 4 * D_MODEL
RMS_EPS = 1e-6
NEG_INF = -1e30
FORCED_SCORE = 1e4
SCALE = HEAD_DIM ** -0.5

FOX_W = FOX_HEADS * HEAD_DIM
NSA_W = NSA_HEADS * HEAD_DIM
KV_W = NSA_KV_GROUPS * HEAD_DIM
IN_SPLITS = (FOX_W, FOX_W, FOX_W, FOX_HEADS,
             NSA_W, KV_W, KV_W, KV_W, KV_W, KV_W, KV_W, 3 * NSA_HEADS,
             D_MODEL, D_MODEL)
IN_WIDTH = sum(IN_SPLITS)

kernel_name = "hybrid_fox_nsa_gated_block"


def rms_norm(x, g):
    xf = x.astype(jnp.float32)
    y = xf * lax.rsqrt(jnp.mean(xf * xf, axis=-1, keepdims=True) + RMS_EPS)
    return (y * g.astype(jnp.float32)).astype(x.dtype)


def masked_softmax(s, mask):
    p = jax.nn.softmax(jnp.where(mask, s, NEG_INF), axis=-1)
    return jnp.where(mask, p, 0.0)


def rel_bucket(dist):
    n = jnp.maximum(dist, 0)
    exact = REL_BUCKETS // 2
    nf = jnp.maximum(n, exact).astype(jnp.float32)
    log_b = exact + (jnp.log(nf / exact) / math.log(REL_MAX_DIST / exact)
                     * (REL_BUCKETS - exact)).astype(jnp.int32)
    return jnp.where(n < exact, n, jnp.minimum(log_b, REL_BUCKETS - 1))


def fox_attention(q, k, v, f_logit, b_f):
    B, T, H, DH = q.shape
    nb = T // Q_BLOCK
    log_f = jax.nn.log_sigmoid(f_logit.astype(jnp.float32) + b_f.astype(jnp.float32))
    c = jnp.cumsum(log_f, axis=1).transpose(0, 2, 1)
    qb = q.reshape(B, nb, Q_BLOCK, H, DH).transpose(1, 0, 3, 2, 4)
    cqb = c.reshape(B, H, nb, Q_BLOCK).transpose(2, 0, 1, 3)
    kpos = jnp.arange(T)

    def block(args):
        i, qi, ci = args
        qpos = i * Q_BLOCK + jnp.arange(Q_BLOCK)
        s = jnp.einsum('bhqd,bkhd->bhqk', qi, k).astype(jnp.float32) * SCALE
        s = s + ci[..., None] - c[:, :, None, :]
        p = masked_softmax(s, kpos[None, :] <= qpos[:, None])
        return jnp.einsum('bhqk,bkhd->bqhd', p.astype(v.dtype), v)

    o = lax.map(block, (jnp.arange(nb), qb, cqb))
    return o.transpose(1, 0, 2, 3, 4).reshape(B, T, H * DH)


def compress_blocks(kv, pe, w1, w2):
    B, T, G, DH = kv.shape
    nc = (T - CMP_BLOCK) // CMP_STRIDE + 1
    idx = np.arange(nc)[:, None] * CMP_STRIDE + np.arange(CMP_BLOCK)[None, :]
    blk = kv[:, idx] + pe[:, None, :]
    blk = blk.transpose(0, 3, 1, 2, 4).reshape(B, G, nc, CMP_BLOCK * DH)
    return jax.nn.silu(blk @ w1) @ w2


def nsa_attention(q, k_cmp, v_cmp, k_slc, v_slc, k_win, v_win, gate_logit, rel_table,
                  pe_k, w1_k, w2_k, pe_v, w1_v, w2_v):
    B, T, H, DH = q.shape
    G, R = NSA_KV_GROUPS, NSA_REP
    nb = T // Q_BLOCK
    nc = (T - CMP_BLOCK) // CMP_STRIDE + 1
    ns = T // SLC_BLOCK
    n_sel = min(SLC_TOPK, ns)

    kc = compress_blocks(k_cmp, pe_k, w1_k, w2_k)
    vc = compress_blocks(v_cmp, pe_v, w1_v, w2_v)
    cmp_start = np.arange(nc) * CMP_STRIDE
    cmp_end = jnp.asarray(cmp_start + CMP_BLOCK - 1, dtype=jnp.int32)
    slc_start = np.arange(ns) * SLC_BLOCK
    overlap = jnp.asarray(((cmp_start[:, None] < slc_start[None, :] + SLC_BLOCK)
                           & (cmp_start[:, None] + CMP_BLOCK > slc_start[None, :])).astype(np.float32))

    tbl_heads = rel_table.T
    tbl_grp = tbl_heads.reshape(G, R, REL_BUCKETS)
    g_idx = jnp.arange(G)[None, :, None, None, None]
    r_idx = jnp.arange(R)[None, None, :, None, None]

    ks = k_slc.transpose(0, 2, 1, 3).reshape(B, G, ns, SLC_BLOCK, DH)
    vs = v_slc.transpose(0, 2, 1, 3).reshape(B, G, ns, SLC_BLOCK, DH)
    pad = ((0, 0), (0, 0), (WINDOW, 0), (0, 0))
    kwp = jnp.pad(k_win.transpose(0, 2, 1, 3), pad)
    vwp = jnp.pad(v_win.transpose(0, 2, 1, 3), pad)
    win_dist = jnp.asarray(np.arange(Q_BLOCK)[:, None] + WINDOW - np.arange(Q_BLOCK + WINDOW)[None, :],
                           dtype=jnp.int32)
    bias_win = tbl_heads[:, rel_bucket(win_dist)].reshape(G, R, Q_BLOCK, Q_BLOCK + WINDOW)

    qb = q.reshape(B, nb, Q_BLOCK, G, R, DH).transpose(1, 0, 3, 4, 2, 5)
    b_idx = jnp.arange(B)[:, None, None, None]
    gk_idx = jnp.arange(G)[None, :, None, None]
    j = jnp.arange(ns)

    def block(args):
        i, qi = args
        qpos = i * Q_BLOCK + jnp.arange(Q_BLOCK)
        s = jnp.einsum('bgrqd,bgcd->bgrqc', qi, kc).astype(jnp.float32) * SCALE
        bias = tbl_heads[:, rel_bucket(qpos[:, None] - cmp_end[None, :])].reshape(G, R, Q_BLOCK, nc)
        p_cmp = masked_softmax(s + bias, cmp_end[None, :] <= qpos[:, None])
        o_cmp = jnp.einsum('bgrqc,bgcd->bgrqd', p_cmp.astype(vc.dtype), vc)
        imp = jnp.einsum('bgrqc,cs->bgqs', p_cmp, overlap)
        cur = qpos // SLC_BLOCK
        forced = (j[None, :] == 0) | (j[None, :] == cur[:, None]) | (j[None, :] == cur[:, None] - 1)
        valid = j[None, :] * SLC_BLOCK <= qpos[:, None]
        imp = jnp.where(forced, FORCED_SCORE, jnp.where(valid, imp, -1.0))
        _, sel = lax.top_k(imp, n_sel)
        k_sel = ks[b_idx, gk_idx, sel].reshape(B, G, Q_BLOCK, n_sel * SLC_BLOCK, DH)
        v_sel = vs[b_idx, gk_idx, sel].reshape(B, G, Q_BLOCK, n_sel * SLC_BLOCK, DH)
        pos = (sel[..., None] * SLC_BLOCK + jnp.arange(SLC_BLOCK)).reshape(B, G, Q_BLOCK, n_sel * SLC_BLOCK)
        s = jnp.einsum('bgrqd,bgqkd->bgrqk', qi, k_sel).astype(jnp.float32) * SCALE
        bias = tbl_grp[g_idx, r_idx, rel_bucket(qpos[:, None] - pos)[:, :, None]]
        p = masked_softmax(s + bias, (pos <= qpos[:, None])[:, :, None])
        o_slc = jnp.einsum('bgrqk,bgqkd->bgrqd', p.astype(v_sel.dtype), v_sel)
        kw = lax.dynamic_slice_in_dim(kwp, i * Q_BLOCK, Q_BLOCK + WINDOW, axis=2)
        vw = lax.dynamic_slice_in_dim(vwp, i * Q_BLOCK, Q_BLOCK + WINDOW, axis=2)
        kpos = i * Q_BLOCK - WINDOW + jnp.arange(Q_BLOCK + WINDOW)
        wmask = ((kpos[None, :] >= 0) & (kpos[None, :] <= qpos[:, None])
                 & (qpos[:, None] - kpos[None, :] < WINDOW))
        s = jnp.einsum('bgrqd,bgkd->bgrqk', qi, kw).astype(jnp.float32) * SCALE + bias_win
        p = masked_softmax(s, wmask)
        o_win = jnp.einsum('bgrqk,bgkd->bgrqd', p.astype(vw.dtype), vw)
        return jnp.stack([o_cmp, o_slc, o_win], axis=-2)

    o = lax.map(block, (jnp.arange(nb), qb))
    o = o.transpose(1, 0, 4, 2, 3, 5, 6).reshape(B, T, H, 3, DH)
    gates = jax.nn.sigmoid(gate_logit)[..., None]
    return jnp.sum(gates * o, axis=3).reshape(B, T, H * DH)


def setup_inputs(seed: int = 0) -> dict:
    key = jax.random.key(seed)
    ks = jax.random.split(key, 20)

    def w(k, shape, fan_in):
        return jax.random.normal(k, shape, jnp.float32) * fan_in ** -0.5

    def gain(k, shape):
        return 1.0 + 0.05 * jax.random.normal(k, shape, jnp.float32)

    nrm = lambda k, shape: jax.random.normal(k, shape, jnp.float32)
    L = DEPTH
    return {
        "x": nrm(ks[0], (BATCH, SEQ, D_MODEL)),
        "rel_bias_table": 0.5 * nrm(ks[1], (REL_BUCKETS, NSA_HEADS)),
        "g_attn": gain(ks[2], (L, D_MODEL)),
        "w_in": w(ks[3], (L, D_MODEL, IN_WIDTH), D_MODEL),
        "b_forget": 3.0 + 0.5 * nrm(ks[4], (L, FOX_HEADS)),
        "cmp_pe_k": 0.5 * nrm(ks[5], (L, CMP_BLOCK, HEAD_DIM)),
        "cmp_w1_k": w(ks[6], (L, CMP_BLOCK * HEAD_DIM, CMP_HIDDEN), CMP_BLOCK * HEAD_DIM),
        "cmp_w2_k": w(ks[7], (L, CMP_HIDDEN, HEAD_DIM), CMP_HIDDEN),
        "cmp_pe_v": 0.5 * nrm(ks[8], (L, CMP_BLOCK, HEAD_DIM)),
        "cmp_w1_v": w(ks[9], (L, CMP_BLOCK * HEAD_DIM, CMP_HIDDEN), CMP_BLOCK * HEAD_DIM),
        "cmp_w2_v": w(ks[10], (L, CMP_HIDDEN, HEAD_DIM), CMP_HIDDEN),
        "w_br_fox": w(ks[11], (L, FOX_W, D_MODEL), FOX_W),
        "w_br_nsa": w(ks[12], (L, NSA_W, D_MODEL), NSA_W),
        "w_out": w(ks[13], (L, D_MODEL, D_MODEL), D_MODEL),
        "g_mlp": gain(ks[14], (L, D_MODEL)),
        "w_ff1": w(ks[15], (L, D_MODEL, D_FF), D_MODEL),
        "w_ff2": w(ks[16], (L, D_FF, D_MODEL), D_FF),
        "g_final": gain(ks[17], (D_MODEL,)),
    }


def reference(x, rel_bias_table, g_attn, w_in, b_forget, cmp_pe_k, cmp_w1_k, cmp_w2_k,
              cmp_pe_v, cmp_w1_v, cmp_w2_v, w_br_fox, w_br_nsa, w_out, g_mlp, w_ff1, w_ff2,
              g_final):
    B, T, _ = x.shape
    offsets = np.cumsum(IN_SPLITS)[:-1].tolist()
    for l in range(DEPTH):
        h = rms_norm(x, g_attn[l])
        z = h @ w_in[l]
        (fq, fk, fv, f_logit, nq, kc, vc, ksl, vsl, kwn, vwn, n_gate, g_a, g_b) = jnp.split(z, offsets, axis=-1)
        fox_h = lambda t: t.reshape(B, T, FOX_HEADS, HEAD_DIM)
        kv_h = lambda t: t.reshape(B, T, NSA_KV_GROUPS, HEAD_DIM)
        o_fox = fox_attention(fox_h(fq), fox_h(fk), fox_h(fv), f_logit, b_forget[l])
        o_nsa = nsa_attention(nq.reshape(B, T, NSA_HEADS, HEAD_DIM), kv_h(kc), kv_h(vc), kv_h(ksl), kv_h(vsl),
                              kv_h(kwn), kv_h(vwn), n_gate.reshape(B, T, NSA_HEADS, 3), rel_bias_table,
                              cmp_pe_k[l], cmp_w1_k[l], cmp_w2_k[l], cmp_pe_v[l], cmp_w1_v[l], cmp_w2_v[l])
        merged = jax.nn.sigmoid(g_a) * (o_fox @ w_br_fox[l]) + jax.nn.sigmoid(g_b) * (o_nsa @ w_br_nsa[l])
        x = x + merged @ w_out[l]
        h = rms_norm(x, g_mlp[l])
        x = x + jnp.square(jax.nn.relu(h @ w_ff1[l])) @ w_ff2[l]
    return rms_norm(x, g_final)
```

```cpp
#include <hip/hip_runtime.h>
#include <hip/hip_cooperative_groups.h>
#include <hip/hip_bf16.h>
#include <cstdio>
#include <cstdint>
#include <cmath>
namespace cg = cooperative_groups;

#define LAS __attribute__((address_space(3)))
#define GAS __attribute__((address_space(1)))
typedef unsigned short bf16_t;
typedef short bf16x8 __attribute__((ext_vector_type(8)));
typedef short s16x4 __attribute__((ext_vector_type(4)));
typedef float f32x4 __attribute__((ext_vector_type(4)));
typedef float f32x2 __attribute__((ext_vector_type(2)));
typedef float f32x16 __attribute__((ext_vector_type(16)));
typedef unsigned u32x4 __attribute__((ext_vector_type(4)));
typedef unsigned u32x2 __attribute__((ext_vector_type(2)));
typedef __bf16 bf16x2_t __attribute__((ext_vector_type(2)));

constexpr int BATCH = 4, T = 4096, D = 1024, M = BATCH * T, FF = 4096;
constexpr int NIN = 5120;
constexpr int NKV = 2, NH = 8, HD = 64;
constexpr float RMS_EPS = 1e-6f;
constexpr float LOG2E = 1.4426950408889634f;
constexpr float C2 = 0.125f * LOG2E;
constexpr float NEGBIG = -1.0e30f;
constexpr int NWAVES = 8;

constexpr size_t MiB = 1u << 20;
constexpr size_t WS_CTL = 0, CTL_ZERO_BYTES = 64 * 1024;
constexpr size_t WS_CB1 = 4096;
constexpr size_t WS_LUT = 1 * MiB;
constexpr size_t WS_CW2T = 1 * MiB + 64 * 1024;
constexpr size_t WS_SSQ1 = 2 * MiB, WS_SSQ2 = 3 * MiB;
constexpr size_t WS_WIN = 4 * MiB;
constexpr size_t WS_WF = 14 * MiB, WS_WN = 15 * MiB;
constexpr size_t WS_WOUT = 16 * MiB;
constexpr size_t WS_W1 = 18 * MiB, WS_W2 = 26 * MiB;
constexpr size_t WS_CW1 = 34 * MiB;
constexpr size_t WS_KC = 36 * MiB;
constexpr size_t WS_FB = 37 * MiB;
constexpr size_t WS_SMALL = 41 * MiB;
constexpr size_t WS_XN = 44 * MiB;
constexpr size_t WS_OFOX = 44 * MiB, WS_ONSA = 60 * MiB;
constexpr size_t WS_FQ = 76 * MiB, WS_FK = 92 * MiB, WS_FV = 108 * MiB, WS_NQ = 124 * MiB;
constexpr size_t WS_KV6 = 140 * MiB;
constexpr size_t KV6_ELEMS = (size_t)BATCH * NKV * T * HD;
constexpr size_t WS_GA = 165 * MiB, WS_GB = 197 * MiB;
constexpr size_t WS_MERGED = 76 * MiB;
constexpr size_t WS_H = 76 * MiB;
constexpr size_t WS_END = 229 * MiB;

constexpr int LDS_BYTES = 147456;
constexpr int KSLOT = 10240, VSLOT = 8192;
constexpr int L_K = 0, L_V = 2 * KSLOT, L_WSF = L_V + 2 * VSLOT, L_OST = L_WSF + 2048, L_LUT = L_OST + 8 * 8192, L_ATT_END = L_LUT + 4 * 384 * 4;
static_assert(L_ATT_END <= 131072, "attention LDS");

__device__ __forceinline__ unsigned cvtpk(float lo, float hi) { f32x2 v = {lo, hi}; bf16x2_t b = __builtin_convertvector(v, bf16x2_t); return __builtin_bit_cast(unsigned, b); }
__device__ __forceinline__ float bf_lo(unsigned w) { return __uint_as_float(w << 16); }
__device__ __forceinline__ float bf_hi(unsigned w) { return __uint_as_float(w & 0xffff0000u); }
__device__ __forceinline__ float fsigmoid(float x) { return __builtin_amdgcn_rcpf(1.0f + __builtin_amdgcn_exp2f(-x * LOG2E)); }
__device__ __forceinline__ int crow(int r, int hi) { return (r & 3) + 8 * (r >> 2) + 4 * hi; }
#define SBAR() __builtin_amdgcn_sched_barrier(0)
#define OPAQUE(x) asm volatile("" : "+v"(x))
#define LDS_WAIT() asm volatile("s_waitcnt lgkmcnt(0)" ::: "memory")
#define VM_WAIT() asm volatile("s_waitcnt vmcnt(0)" ::: "memory")

namespace pg8 {
constexpr int BM = 256, BK = 64, HALF = 128, HTB = HALF * BK * 2, STAGE_BYTES = 8 * HTB, NXCD = 8, WGM = 8;
__host__ __device__ __forceinline__ int lds_byte(int r, int c) { const int st = (r >> 4) * 2 + (c >> 5), rr = r & 15, cc = c & 31, ob = rr * 64 + cc * 2; return st * 1024 + (ob ^ (((ob >> 9) & 1) << 5)); }
__host__ __device__ __forceinline__ void stage_rc(int b, int& R, int& C) { const int st = b / 1024, sb = b % 1024, swz = sb ^ (((sb >> 9) & 1) << 5); R = (st >> 1) * 16 + swz / 64; C = (st & 1) * 32 + (swz % 64) / 2; }
__host__ __device__ __forceinline__ int perm32(int rho) { const int n = rho >> 4, i = rho & 15; return 8 * (i >> 2) + 4 * n + (i & 3); }

struct Unit { int pm, pn, w; };
struct Gemm { const bf16_t* A0; const bf16_t* A1; const bf16_t* B0; const bf16_t* B1; int M, N, K; };

struct StaticOrder {
    int nM, nN, nwg, G, c, dual;
    __device__ void init(int M_, int N_, int G_, int c_, int dual_) { nM = M_ / BM; nN = N_ / BM; nwg = nM * nN; G = G_; c = c_; dual = dual_; }
    __device__ bool next(int i, Unit& u) const {
        const int ti = dual ? (i >> 1) : i; u.w = dual ? (i & 1) : 0;
        const long L = (long)ti * G + c; if (L >= nwg) return false;
        int wgid = (int)L; { const int q = nwg / NXCD, r = nwg % NXCD, xcd = wgid % NXCD, off = wgid / NXCD; wgid = (xcd < r ? xcd * (q + 1) : r * (q + 1) + (xcd - r) * q) + off; }
        const int nig = WGM * nN, gid = wgid / nig, fm = gid * WGM, gsz = (nM - fm) < WGM ? (nM - fm) : WGM;
        u.pm = fm + ((wgid % nig) % gsz); u.pn = (wgid % nig) / gsz; return true;
    }
};

typedef f32x4 Acc[2][2][4][2];

template <class Epi, bool ALIGN_EPI, bool SP2>
__device__ __forceinline__ void gemm_phase(LAS unsigned char* lds, const Gemm g, const StaticOrder& S, const Epi& E) {
    const int tid = threadIdx.x, wid = __builtin_amdgcn_readfirstlane(tid >> 6), lane = tid & 63, wr = wid >> 2, wc = wid & 3, fr = lane & 15, fq = lane >> 4;
    const int K = g.K, nt = K / BK;
    unsigned voffA[2], voffB[2];
#pragma unroll
    for (int i = 0; i < 2; ++i) { int R, C; stage_rc(tid * 16 + i * 8192, R, C); const int Rb = Epi::PERM ? ((R & ~31) + perm32(R & 31)) : R;
        voffA[i] = (unsigned)(R * K + C) * 2u; voffB[i] = (unsigned)(Rb * K + C) * 2u; }
    const size_t kstep = (size_t)(BK * 2);
    const size_t hstep = (size_t)HALF * K * 2;
    const size_t tstep = 2 * hstep;
    const unsigned ldsw = (unsigned)wid * 1024u;
    const int aoff = lds_byte(wr * 64 + fr, fq * 8), boff = lds_byte(wc * 32 + fr, fq * 8);
#define PG8_SA(b, h) (((b) * 2 + (h)) * HTB)
#define PG8_SB(b, h) ((4 + (b) * 2 + (h)) * HTB)
#define PG8_STAGE(bufoff, gbase, voff) do { _Pragma("unroll") for (int _i = 0; _i < 2; ++_i) \
        __builtin_amdgcn_global_load_lds((const unsigned*)((const char*)(gbase) + (voff)[_i]), (LAS unsigned*)(lds + (bufoff) + ldsw + _i * 8192), 16, 0, 0); } while (0)
#define PG8_LDA(dst, b, h) do { _Pragma("unroll") for (int m = 0; m < 4; ++m) _Pragma("unroll") for (int k = 0; k < 2; ++k) dst[m][k] = *(const LAS bf16x8*)(lds + PG8_SA(b, h) + aoff + m * 2048 + k * 1024); } while (0)
#define PG8_LDB(dst, b, h) do { _Pragma("unroll") for (int n = 0; n < 2; ++n) _Pragma("unroll") for (int k = 0; k < 2; ++k) dst[n][k] = *(const LAS bf16x8*)(lds + PG8_SB(b, h) + boff + n * 2048 + k * 1024); } while (0)
#define PG8_MMA(ai, bj, At, Bt) do { __builtin_amdgcn_s_setprio(1); _Pragma("unroll") for (int m = 0; m < 4; ++m) _Pragma("unroll") for (int n = 0; n < 2; ++n) _Pragma("unroll") for (int k = 0; k < 2; ++k) \
        acc[ai][bj][m][n] = __builtin_amdgcn_mfma_f32_16x16x32_bf16(Bt[n][k], At[m][k], acc[ai][bj][m][n], 0, 0, 0); __builtin_amdgcn_s_setprio(0); } while (0)
#define PG8_WAIT_V(n) asm volatile("s_waitcnt vmcnt(" #n ")" ::: "memory")
#define PG8_WAIT_L(n) asm volatile("s_waitcnt lgkmcnt(" #n ")" ::: "memory")
#define PG8_BAR __builtin_amdgcn_s_barrier()
#define PG8_SCHED __builtin_amdgcn_sched_barrier(0)
    Unit cur, nxt; int ui = 0;
    if (!S.next(0, cur)) return;
    Acc acc;
#pragma unroll
    for (int a = 0; a < 2; ++a)
#pragma unroll
        for (int b = 0; b < 2; ++b)
#pragma unroll
            for (int m = 0; m < 4; ++m)
#pragma unroll
                for (int n = 0; n < 2; ++n) acc[a][b][m][n] = (f32x4){0.f, 0.f, 0.f, 0.f};
    bf16x8 At[4][2], B0[2][2], B1[2][2];
    const char* cA = (const char*)(cur.w ? g.A1 : g.A0) + (size_t)cur.pm * tstep; const char* cB = (const char*)(cur.w ? g.B1 : g.B0) + (size_t)cur.pn * tstep;
    if constexpr (SP2) {
        PG8_STAGE(PG8_SB(0, 0), cB, voffB); PG8_STAGE(PG8_SB(0, 1), cB + hstep, voffB); PG8_STAGE(PG8_SA(0, 0), cA, voffA); PG8_STAGE(PG8_SA(0, 1), cA + hstep, voffA);
        if (wr == 1) PG8_BAR;
        PG8_WAIT_V(2); PG8_BAR;
        PG8_STAGE(PG8_SB(1, 0), cB + kstep, voffB); PG8_STAGE(PG8_SA(1, 0), cA + kstep, voffA); PG8_STAGE(PG8_SB(1, 1), cB + hstep + kstep, voffB);
        PG8_WAIT_V(6); PG8_BAR;
    } else {
        PG8_STAGE(PG8_SB(0, 0), cB, voffB); PG8_STAGE(PG8_SA(0, 0), cA, voffA); PG8_STAGE(PG8_SB(0, 1), cB + hstep, voffB); PG8_STAGE(PG8_SA(0, 1), cA + hstep, voffA);
        if (wr == 1) PG8_BAR;
        PG8_WAIT_V(4); PG8_BAR;
        PG8_STAGE(PG8_SB(1, 0), cB + kstep, voffB); PG8_STAGE(PG8_SA(1, 0), cA + kstep, voffA); PG8_STAGE(PG8_SB(1, 1), cB + hstep + kstep, voffB);
        PG8_WAIT_V(6); PG8_BAR;
    }
    for (;;) {
        const bool has_next = S.next(ui + 1, nxt);
        const char* nA = has_next ? (const char*)(nxt.w ? g.A1 : g.A0) + (size_t)nxt.pm * tstep : cA; const char* nB = has_next ? (const char*)(nxt.w ? g.B1 : g.B0) + (size_t)nxt.pn * tstep : cB;
        for (int t = 0; t < nt; t += 2) {
            const bool last = (t == nt - 2);
            const char* a1 = cA + (size_t)(t + 1) * kstep;
            const char* a2 = last ? nA : cA + (size_t)(t + 2) * kstep; const char* b2 = last ? nB : cB + (size_t)(t + 2) * kstep;
            const char* a3 = a2 + kstep; const char* b3 = b2 + kstep;
            if constexpr (SP2) {
            PG8_LDB(B0, 0, 0); PG8_LDB(B1, 0, 1); PG8_SCHED; PG8_LDA(At, 0, 0); PG8_STAGE(PG8_SA(1, 1), a1 + hstep, voffA);
            PG8_WAIT_V(8); PG8_WAIT_L(0); PG8_BAR; PG8_MMA(0, 0, At, B0); PG8_MMA(0, 1, At, B1); PG8_BAR; PG8_SCHED;
            PG8_LDA(At, 0, 1); PG8_STAGE(PG8_SB(0, 0), b2, voffB); PG8_STAGE(PG8_SB(0, 1), b2 + hstep, voffB); PG8_STAGE(PG8_SA(0, 0), a2, voffA);
            PG8_WAIT_V(8); PG8_WAIT_L(0); PG8_BAR; PG8_MMA(1, 0, At, B0); PG8_MMA(1, 1, At, B1); PG8_BAR; PG8_SCHED;
            PG8_LDB(B0, 1, 0); PG8_LDB(B1, 1, 1); PG8_SCHED; PG8_LDA(At, 1, 0); PG8_STAGE(PG8_SA(0, 1), a2 + hstep, voffA);
            PG8_WAIT_V(8); PG8_WAIT_L(0); PG8_BAR; PG8_MMA(0, 0, At, B0); PG8_MMA(0, 1, At, B1); PG8_BAR; PG8_SCHED;
            PG8_LDA(At, 1, 1); PG8_STAGE(PG8_SB(1, 0), b3, voffB); PG8_STAGE(PG8_SB(1, 1), b3 + hstep, voffB); PG8_STAGE(PG8_SA(1, 0), a3, voffA);
            PG8_WAIT_V(8); PG8_WAIT_L(0); PG8_BAR; PG8_MMA(1, 0, At, B0); PG8_MMA(1, 1, At, B1); PG8_BAR; PG8_SCHED;
            } else {
            PG8_LDB(B0, 0, 0); PG8_SCHED; PG8_LDA(At, 0, 0); PG8_STAGE(PG8_SA(1, 1), a1 + hstep, voffA);
            PG8_WAIT_L(8); PG8_BAR; PG8_WAIT_L(0); PG8_MMA(0, 0, At, B0); PG8_BAR; PG8_SCHED;
            PG8_LDB(B1, 0, 1); PG8_STAGE(PG8_SB(0, 0), b2, voffB);
            PG8_BAR; PG8_WAIT_L(0); PG8_MMA(0, 1, At, B1); PG8_BAR;
            PG8_LDA(At, 0, 1); PG8_STAGE(PG8_SA(0, 0), a2, voffA);
            PG8_BAR; PG8_WAIT_L(0); PG8_MMA(1, 0, At, B0); PG8_BAR; PG8_SCHED;
            PG8_STAGE(PG8_SB(0, 1), b2 + hstep, voffB);
            PG8_WAIT_V(6); PG8_BAR; PG8_MMA(1, 1, At, B1); PG8_BAR;
            PG8_LDB(B0, 1, 0); PG8_SCHED; PG8_LDA(At, 1, 0); PG8_STAGE(PG8_SA(0, 1), a2 + hstep, voffA);
            PG8_WAIT_L(8); PG8_BAR; PG8_WAIT_L(0); PG8_MMA(0, 0, At, B0); PG8_BAR; PG8_SCHED;
            PG8_LDB(B1, 1, 1); PG8_STAGE(PG8_SB(1, 0), b3, voffB);
            PG8_BAR; PG8_WAIT_L(0); PG8_MMA(0, 1, At, B1); PG8_BAR;
            PG8_LDA(At, 1, 1); PG8_STAGE(PG8_SA(1, 0), a3, voffA);
            PG8_BAR; PG8_WAIT_L(0); PG8_MMA(1, 0, At, B0); PG8_BAR; PG8_SCHED;
            PG8_STAGE(PG8_SB(1, 1), b3 + hstep, voffB);
            PG8_WAIT_V(6); PG8_BAR; PG8_MMA(1, 1, At, B1); PG8_BAR;
            }
        }
        if constexpr (ALIGN_EPI) { if (wr == 0) PG8_BAR; }
        const bool keep = Epi::DUAL && (cur.w == 0);
        if (keep) E.mid(acc, cur, wr, wc, fr, fq); else E(acc, cur, wr, wc, fr, fq);
        if (!has_next) break;
        if (!keep) {
#pragma unroll
        for (int a = 0; a < 2; ++a)
#pragma unroll
            for (int b = 0; b < 2; ++b)
#pragma unroll
                for (int m = 0; m < 4; ++m)
#pragma unroll
                    for (int n = 0; n < 2; ++n) acc[a][b][m][n] = (f32x4){0.f, 0.f, 0.f, 0.f};
        }
        cur = nxt; cA = nA; cB = nB; ++ui;
        if constexpr (ALIGN_EPI) { if (wr == 1) PG8_BAR; }
    }
    PG8_WAIT_V(0);
    if constexpr (!ALIGN_EPI) { if (wr == 0) PG8_BAR; }
    PG8_BAR;
#undef PG8_SA
#undef PG8_SB
#undef PG8_STAGE
#undef PG8_LDA
#undef PG8_LDB
#undef PG8_MMA
#undef PG8_WAIT_V
#undef PG8_WAIT_L
#undef PG8_BAR
#undef PG8_SCHED
}

__device__ __forceinline__ u32x4 pack8(f32x4 v0, f32x4 v1) { u32x4 w; w.x = cvtpk(v0[0], v0[1]); w.y = cvtpk(v0[2], v0[3]); w.z = cvtpk(v1[0], v1[1]); w.w = cvtpk(v1[2], v1[3]); return w; }

struct EpiQKV {
    static constexpr bool PERM = true, DUAL = false;
    bf16_t *FQ, *FK, *FV, *NQ, *KV6, *GA, *GB; float* SMALL;
    __device__ __forceinline__ void mid(Acc& acc, const Unit& u, int wr, int wc, int fr, int fq) const {}
    __device__ __forceinline__ void operator()(const Acc& acc, const Unit& u, int wr, int wc, int fr, int fq) const {
        const int pn = u.pn, row0 = u.pm * BM + wr * 64 + fr, cl = wc * 32 + 8 * fq;
#pragma unroll
        for (int ai = 0; ai < 2; ++ai)
#pragma unroll
            for (int m = 0; m < 4; ++m) { const int row = row0 + ai * HALF + m * 16;
#pragma unroll
                for (int bj = 0; bj < 2; ++bj) { f32x4 v0 = acc[ai][bj][m][0], v1 = acc[ai][bj][m][1]; const int c = bj * HALF + cl;
                    if (pn < 8) { bf16_t* base = FQ + (size_t)(pn >> 1) * (8u << 20); const float sc = (pn < 2 || pn >= 6) ? C2 : 1.f;
                        *(u32x4*)(base + (size_t)row * 512 + (pn & 1) * 256 + c) = pack8(v0 * sc, v1 * sc);
                    } else if (pn < 11) { const int n6 = (pn - 8) * 256 + c, which = n6 >> 7, gg = (n6 >> 6) & 1, d = n6 & 63, b = row >> 12, t = row & 4095;
                        *(u32x4*)(KV6 + (size_t)which * KV6_ELEMS + ((size_t)((b * 2 + gg) * T + t) * 64 + d)) = pack8(v0, v1);
                    } else if (pn < 19) { bf16_t* base = GA + (size_t)((pn - 11) >> 2) * (16u << 20); const int col = ((pn - 11) & 3) * 256 + c;
                        f32x4 s0, s1;
#pragma unroll
                        for (int e = 0; e < 4; ++e) { s0[e] = fsigmoid(v0[e]); s1[e] = fsigmoid(v1[e]); }
                        *(u32x4*)(base + (size_t)row * 1024 + col) = pack8(s0, s1);
                    } else { if (c < 32) { *(f32x4*)(SMALL + (size_t)row * 32 + c) = v0; *(f32x4*)(SMALL + (size_t)row * 32 + c + 4) = v1; } }
                } }
    }
};
struct EpiMerge {
    static constexpr bool PERM = true, DUAL = true;
    const bf16_t *GA, *GB; bf16_t* OUT;
    __device__ __forceinline__ void mid(Acc& acc, const Unit& u, int wr, int wc, int fr, int fq) const {
        const int row0 = u.pm * BM + wr * 64 + fr, col0 = u.pn * BM + wc * 32 + 8 * fq;
#pragma unroll
        for (int ai = 0; ai < 2; ++ai)
#pragma unroll
            for (int m = 0; m < 4; ++m) { const size_t ro = (size_t)(row0 + ai * HALF + m * 16) * 1024 + col0;
#pragma unroll
                for (int bj = 0; bj < 2; ++bj) { const u32x4 a = *(const u32x4*)(GA + ro + bj * HALF), b = *(const u32x4*)(GB + ro + bj * HALF);
                    f32x4 r0, r1;
                    r0[0] = bf_lo(a.x) * __builtin_amdgcn_rcpf(bf_lo(b.x)); r0[1] = bf_hi(a.x) * __builtin_amdgcn_rcpf(bf_hi(b.x));
                    r0[2] = bf_lo(a.y) * __builtin_amdgcn_rcpf(bf_lo(b.y)); r0[3] = bf_hi(a.y) * __builtin_amdgcn_rcpf(bf_hi(b.y));
                    r1[0] = bf_lo(a.z) * __builtin_amdgcn_rcpf(bf_lo(b.z)); r1[1] = bf_hi(a.z) * __builtin_amdgcn_rcpf(bf_hi(b.z));
                    r1[2] = bf_lo(a.w) * __builtin_amdgcn_rcpf(bf_lo(b.w)); r1[3] = bf_hi(a.w) * __builtin_amdgcn_rcpf(bf_hi(b.w));
                    acc[ai][bj][m][0] *= r0; acc[ai][bj][m][1] *= r1; } }
    }
    __device__ __forceinline__ void operator()(const Acc& acc, const Unit& u, int wr, int wc, int fr, int fq) const {
        const int row0 = u.pm * BM + wr * 64 + fr, col0 = u.pn * BM + wc * 32 + 8 * fq;
#pragma unroll
        for (int ai = 0; ai < 2; ++ai)
#pragma unroll
            for (int m = 0; m < 4; ++m) { const size_t ro = (size_t)(row0 + ai * HALF + m * 16) * 1024 + col0;
#pragma unroll
                for (int bj = 0; bj < 2; ++bj) { const u32x4 b = *(const u32x4*)(GB + ro + bj * HALF);
                    const f32x4 g0 = {bf_lo(b.x), bf_hi(b.x), bf_lo(b.y), bf_hi(b.y)}, g1 = {bf_lo(b.z), bf_hi(b.z), bf_lo(b.w), bf_hi(b.w)};
                    *(u32x4*)(OUT + ro + bj * HALF) = pack8(acc[ai][bj][m][0] * g0, acc[ai][bj][m][1] * g1); } }
    }
};
struct EpiRes {
    static constexpr bool PERM = false, DUAL = false;
    const float* base; float* out; bf16_t* xb; float* ssqp;
    __device__ __forceinline__ void mid(Acc& acc, const Unit& u, int wr, int wc, int fr, int fq) const {}
    __device__ __forceinline__ void operator()(const Acc& acc, const Unit& u, int wr, int wc, int fr, int fq) const {
        const int row0 = u.pm * BM + wr * 64 + fr, col0 = u.pn * BM + wc * 32 + 4 * fq;
#pragma unroll
        for (int ai = 0; ai < 2; ++ai)
#pragma unroll
            for (int m = 0; m < 4; ++m) { const int row = row0 + ai * HALF + m * 16; const size_t ro = (size_t)row * 1024 + col0; float ss = 0.f;
#pragma unroll
                for (int bj = 0; bj < 2; ++bj)
#pragma unroll
                    for (int n = 0; n < 2; ++n) { const size_t o = ro + bj * HALF + n * 16; const f32x4 v = *(const f32x4*)(base + o) + acc[ai][bj][m][n];
                        *(f32x4*)(out + o) = v; ss += (v[0] * v[0] + v[1] * v[1]) + (v[2] * v[2] + v[3] * v[3]);
                        if (xb) { u32x2 w; w.x = cvtpk(v[0], v[1]); w.y = cvtpk(v[2], v[3]); *(u32x2*)(xb + o) = w; } }
                ss += __shfl_xor(ss, 16); ss += __shfl_xor(ss, 32);
                if (fq == 0) ssqp[(size_t)row * 16 + u.pn * 4 + wc] = ss; }
    }
};
struct EpiFF1 {
    static constexpr bool PERM = true, DUAL = false;
    const float* ssqp; bf16_t* H;
    __device__ __forceinline__ void mid(Acc& acc, const Unit& u, int wr, int wc, int fr, int fq) const {}
    __device__ __forceinline__ void operator()(const Acc& acc, const Unit& u, int wr, int wc, int fr, int fq) const {
        const int row0 = u.pm * BM + wr * 64 + fr, col0 = u.pn * BM + wc * 32 + 8 * fq;
#pragma unroll
        for (int ai = 0; ai < 2; ++ai)
#pragma unroll
            for (int m = 0; m < 4; ++m) { const int row = row0 + ai * HALF + m * 16;
                const f32x4* sp = (const f32x4*)(ssqp + (size_t)row * 16); const f32x4 s = (sp[0] + sp[1]) + (sp[2] + sp[3]);
                const float rstd = __builtin_amdgcn_rsqf(((s[0] + s[1]) + (s[2] + s[3])) * (1.0f / D) + RMS_EPS);
#pragma unroll
                for (int bj = 0; bj < 2; ++bj) { f32x4 v0 = acc[ai][bj][m][0] * rstd, v1 = acc[ai][bj][m][1] * rstd;
#pragma unroll
                    for (int e = 0; e < 4; ++e) { const float a = fmaxf(v0[e], 0.f), b = fmaxf(v1[e], 0.f); v0[e] = a * a; v1[e] = b * b; }
                    *(u32x4*)(H + (size_t)row * FF + col0 + bj * HALF) = pack8(v0, v1); } }
    }
};
}

struct Args {
    const float *x, *rel, *g_attn, *w_in, *b_forget, *pe_k, *cw1_k, *cw2_k, *pe_v, *cw1_v, *cw2_v, *w_br_fox, *w_br_nsa, *w_out, *g_mlp, *w_ff1, *w_ff2, *g_final;
    float* out; unsigned char* ws; int ph_lo, ph_hi;
};
struct Frame { LAS unsigned char* lds; int tid, lane, wave, G, bid; };

__device__ __forceinline__ float wave_sum(float v) {
#pragma unroll
    for (int o = 1; o < 64; o <<= 1) v += __shfl_xor(v, o);
    return v;
}

__device__ __forceinline__ int win_srccol(int n) {
    if (n < 1536) return n; if (n < 2816) return n + 8; if (n < 4864) return n + 32;
    if (n < 4872) return n - 4864 + 1536; if (n < 4896) return n - 4872 + 2824; return -1;
}
template <bool MAP>
__device__ __forceinline__ void transpose_item(const float* W, int K, int Nsrc, int nblk, bf16_t* WT, LAS float* scr, int item, int lane, const float* kscale) {
    const int kb = item / nblk, nb = item % nblk, k0 = 64 * kb, n0 = 32 * nb;
    const int nd = n0 + (lane & 31), ns = MAP ? win_srccol(nd) : nd;
#pragma unroll 8
    for (int i = 0; i < 32; ++i) { const int kk = 2 * i + (lane >> 5); float v = (ns >= 0) ? W[(size_t)(k0 + kk) * Nsrc + ns] : 0.f; if (kscale) v *= kscale[k0 + kk]; scr[kk * 33 + (lane & 31)] = v; }
    LDS_WAIT(); asm volatile("" ::: "memory");
    const int c = lane & 7;
#pragma unroll
    for (int j = 0; j < 4; ++j) { const int n = (lane >> 3) + 8 * j; const LAS float* s = scr + (8 * c) * 33 + n;
        u32x4 o; o.x = cvtpk(s[0 * 33], s[1 * 33]); o.y = cvtpk(s[2 * 33], s[3 * 33]); o.z = cvtpk(s[4 * 33], s[5 * 33]); o.w = cvtpk(s[6 * 33], s[7 * 33]);
        *(u32x4*)(WT + (size_t)(n0 + n) * K + k0 + 8 * c) = o; }
    LDS_WAIT(); asm volatile("" ::: "memory");
}
__device__ __forceinline__ int rel_bucket(int n) {
    if (n < 16) return n;
    int lb = 16 + (int)(logf((float)n / 16.0f) / 2.0794415416798357f * 16.0f);
    return lb < 31 ? lb : 31;
}
__device__ __forceinline__ void p0_prologue(const Frame& F, const Args& a) {
    unsigned char* ws = a.ws;
    LAS float* scr = (LAS float*)(F.lds + F.wave * 16384);
    const int gw = F.bid * NWAVES + F.wave, NGW = F.G * NWAVES;
    constexpr int I_IN = 16 * 160, I_BR = 8 * 32, I_OUT = 16 * 32, I_1 = 16 * 128, I_2 = 64 * 32, I_C1 = 32 * 8, I_C2 = 4 * 2;
    constexpr int NITEMS = I_IN + 2 * I_BR + I_OUT + I_1 + I_2 + 2 * I_C1 + 2 * I_C2;
    for (int it = gw; it < NITEMS; it += NGW) {
        int r = it;
        if (r < I_IN) { transpose_item<true>(a.w_in, 1024, 4896, 160, (bf16_t*)(ws + WS_WIN), scr, r, F.lane, nullptr); continue; } r -= I_IN;
        if (r < I_BR) { transpose_item<false>(a.w_br_fox, 512, 1024, 32, (bf16_t*)(ws + WS_WF), scr, r, F.lane, nullptr); continue; } r -= I_BR;
        if (r < I_BR) { transpose_item<false>(a.w_br_nsa, 512, 1024, 32, (bf16_t*)(ws + WS_WN), scr, r, F.lane, nullptr); continue; } r -= I_BR;
        if (r < I_OUT) { transpose_item<false>(a.w_out, 1024, 1024, 32, (bf16_t*)(ws + WS_WOUT), scr, r, F.lane, nullptr); continue; } r -= I_OUT;
        if (r < I_1) { transpose_item<false>(a.w_ff1, 1024, 4096, 128, (bf16_t*)(ws + WS_W1), scr, r, F.lane, a.g_mlp); continue; } r -= I_1;
        if (r < I_2) { transpose_item<false>(a.w_ff2, 4096, 1024, 32, (bf16_t*)(ws + WS_W2), scr, r, F.lane, nullptr); continue; } r -= I_2;
        if (r < I_C1) { transpose_item<false>(a.cw1_k, 2048, 256, 8, (bf16_t*)(ws + WS_CW1), scr, r, F.lane, nullptr); continue; } r -= I_C1;
        if (r < I_C1) { transpose_item<false>(a.cw1_v, 2048, 256, 8, (bf16_t*)(ws + WS_CW1) + 256 * 2048, scr, r, F.lane, nullptr); continue; } r -= I_C1;
        if (r < I_C2) { transpose_item<false>(a.cw2_k, 256, 64, 2, (bf16_t*)(ws + WS_CW2T), scr, r, F.lane, nullptr); continue; } r -= I_C2;
        transpose_item<false>(a.cw2_v, 256, 64, 2, (bf16_t*)(ws + WS_CW2T) + 64 * 256, scr, r, F.lane, nullptr);
    }
    {
        bf16_t* XN = (bf16_t*)(ws + WS_XN);
        const f32x4* gp = (const f32x4*)a.g_attn + F.lane; f32x4 gv[4];
#pragma unroll
        for (int j = 0; j < 4; ++j) gv[j] = gp[64 * j];
        for (int m = gw; m < M; m += NGW) {
            const f32x4* xr = (const f32x4*)(a.x + (size_t)m * D) + F.lane; f32x4 v[4]; float s = 0.f;
#pragma unroll
            for (int j = 0; j < 4; ++j) { v[j] = xr[64 * j]; s += (v[j][0] * v[j][0] + v[j][1] * v[j][1]) + (v[j][2] * v[j][2] + v[j][3] * v[j][3]); }
            const float rstd = 1.0f / sqrtf(wave_sum(s) * (1.0f / D) + RMS_EPS);
            u32x2* o8 = (u32x2*)(XN + (size_t)m * D) + F.lane;
#pragma unroll
            for (int j = 0; j < 4; ++j) { const f32x4 y = v[j] * rstd * gv[j]; u32x2 w; w.x = cvtpk(y[0], y[1]); w.y = cvtpk(y[2], y[3]); o8[64 * j] = w; }
        }
    }
    for (int it = gw; it < 64; it += NGW) {
        const int kv = it >> 5, jb = (it >> 3) & 3, ic = it & 7; const float* pe = kv ? a.pe_v : a.pe_k; const float* w1 = kv ? a.cw1_v : a.cw1_k;
        const int j = jb * 64 + F.lane; float s = 0.f;
#pragma unroll 8
        for (int i = ic * 256; i < ic * 256 + 256; ++i) s += pe[i] * w1[(size_t)i * 256 + j];
        atomicAdd((float*)(ws + WS_CB1) + kv * 256 + j, s);
    }
    for (int i = F.bid * 512 + F.tid; i < 8 * 384; i += F.G * 512) {
        const int h = i / 384, e = i % 384; float v;
        if (e < 256) { const int n = e - 64; v = (n < 0) ? NEGBIG : a.rel[rel_bucket(n < 128 ? n : 128) * 8 + h] * LOG2E; }
        else { const int n = 448 + (e - 256); v = (n < 512) ? a.rel[31 * 8 + h] * LOG2E : NEGBIG; }
        ((float*)(ws + WS_LUT))[i] = v;
    }
}

__device__ __forceinline__ float log_sigmoid(float x) { return fminf(x, 0.f) - log1pf(expf(-fabsf(x))); }
__device__ __forceinline__ void scan_seq(const Args& a, int seq, int lane) {
    const int b = seq >> 3, h = seq & 7; const float bf = a.b_forget[h];
    const float* sm = (const float*)(a.ws + WS_SMALL) + ((size_t)b * T + lane * 64) * 32 + h;
    float tot = 0.f;
#pragma unroll 8
    for (int i = 0; i < 64; ++i) tot += log_sigmoid(sm[(size_t)i * 32] + bf);
    float inc = tot;
#pragma unroll
    for (int o = 1; o < 64; o <<= 1) { const float t = __shfl_up(inc, o); if (lane >= o) inc += t; }
    float run = inc - tot;
    u32x4* fb = (u32x4*)((bf16_t*)(a.ws + WS_FB) + ((size_t)seq * T + lane * 64) * 16);
#pragma unroll 4
    for (int i = 0; i < 64; ++i) {
        run += log_sigmoid(sm[(size_t)i * 32] + bf);
        const float v = -run * LOG2E;
        const unsigned w0 = cvtpk(v, 0.f) & 0xffffu; const float r1 = v - __uint_as_float(w0 << 16);
        const unsigned w1 = cvtpk(r1, 0.f) & 0xffffu; const float r2 = r1 - __uint_as_float(w1 << 16);
        const unsigned w2 = cvtpk(r2, 0.f) & 0xffffu;
        fb[2 * i] = (u32x4){w0 | (w1 << 16), w2, 0u, 0u}; fb[2 * i + 1] = (u32x4){0u, 0u, 0u, 0u};
    }
}
__device__ __forceinline__ void compress_unit(const Frame& F, const Args& a, int unit) {
    const int kv = unit >> 5, bg = (unit >> 2) & 7, ct = unit & 3, c0 = ct * 64;
    const int lane = F.lane, r32 = lane & 31, hi = lane >> 5, w = F.wave;
    const bf16_t* data = (const bf16_t*)(a.ws + WS_KV6) + (size_t)kv * KV6_ELEMS + (size_t)bg * T * 64;
    const bf16_t* w1t = (const bf16_t*)(a.ws + WS_CW1) + (size_t)kv * 256 * 2048;
    const bf16_t* w2t = (const bf16_t*)(a.ws + WS_CW2T) + (size_t)kv * 64 * 256;
    const float* cb1 = (const float*)(a.ws + WS_CB1) + kv * 256;
    LAS float* red = (LAS float*)F.lds;
    for (int i = F.tid; i < 4096; i += 512) red[i] = 0.f;
    const bf16_t* ap = w1t + (size_t)(32 * w + r32) * 2048 + 8 * hi;
    const bf16_t* bp0 = data + (size_t)(c0 + r32) * 1024 + 8 * hi;
    const bf16_t* bp1 = bp0 + 32 * 1024;
    f32x16 h0 = {}, h1 = {};
#pragma unroll 4
    for (int ks = 0; ks < 128; ++ks) {
        const bf16x8 af = *(const bf16x8*)(ap + ks * 16), b0 = *(const bf16x8*)(bp0 + ks * 16), b1 = *(const bf16x8*)(bp1 + ks * 16);
        h0 = __builtin_amdgcn_mfma_f32_32x32x16_bf16(af, b0, h0, 0, 0, 0);
        h1 = __builtin_amdgcn_mfma_f32_32x32x16_bf16(af, b1, h1, 0, 0, 0);
    }
#pragma unroll
    for (int r = 0; r < 16; ++r) { const float bj = cb1[32 * w + crow(r, hi)]; float x0 = h0[r] + bj, x1 = h1[r] + bj; h0[r] = x0 * fsigmoid(x0); h1[r] = x1 * fsigmoid(x1); }
    f32x16 po[2][2] = {};
#pragma unroll
    for (int s = 0; s < 2; ++s) {
        bf16x8 xb0, xb1;
        { u32x4 t0, t1;
          t0.x = cvtpk(h0[8 * s + 0], h0[8 * s + 1]); t0.y = cvtpk(h0[8 * s + 2], h0[8 * s + 3]); t0.z = cvtpk(h0[8 * s + 4], h0[8 * s + 5]); t0.w = cvtpk(h0[8 * s + 6], h0[8 * s + 7]);
          t1.x = cvtpk(h1[8 * s + 0], h1[8 * s + 1]); t1.y = cvtpk(h1[8 * s + 2], h1[8 * s + 3]); t1.z = cvtpk(h1[8 * s + 4], h1[8 * s + 5]); t1.w = cvtpk(h1[8 * s + 6], h1[8 * s + 7]);
          xb0 = __builtin_bit_cast(bf16x8, t0); xb1 = __builtin_bit_cast(bf16x8, t1); }
#pragma unroll
        for (int dt = 0; dt < 2; ++dt) {
            const bf16_t* wp = w2t + (size_t)(dt * 32 + r32) * 256 + 32 * w + 16 * s + 4 * hi;
            const u32x2 lo = *(const u32x2*)wp, hi2 = *(const u32x2*)(wp + 8);
            const bf16x8 wa = __builtin_bit_cast(bf16x8, (u32x4){lo.x, lo.y, hi2.x, hi2.y});
            po[dt][0] = __builtin_amdgcn_mfma_f32_32x32x16_bf16(wa, xb0, po[dt][0], 0, 0, 0);
            po[dt][1] = __builtin_amdgcn_mfma_f32_32x32x16_bf16(wa, xb1, po[dt][1], 0, 0, 0);
        }
    }
    __syncthreads();
#pragma unroll
    for (int dt = 0; dt < 2; ++dt)
#pragma unroll
        for (int cti = 0; cti < 2; ++cti)
#pragma unroll
            for (int r = 0; r < 16; ++r) __hip_atomic_fetch_add(red + (cti * 32 + r32) * 64 + dt * 32 + crow(r, hi), po[dt][cti][r], __ATOMIC_RELAXED, __HIP_MEMORY_SCOPE_WORKGROUP);
    __syncthreads();
    { const int c = F.tid >> 3, dc = (F.tid & 7) * 8; const LAS float* s = red + c * 64 + dc;
      u32x4 o; o.x = cvtpk(s[0], s[1]); o.y = cvtpk(s[2], s[3]); o.z = cvtpk(s[4], s[5]); o.w = cvtpk(s[6], s[7]);
      if (c0 + c == 255) o = (u32x4){0u, 0u, 0u, 0u};
      *(u32x4*)((bf16_t*)(a.ws + WS_KC) + ((size_t)(kv * 8 + bg) * 256 + c0 + c) * 64 + dc) = o; }
    __syncthreads();
}

__device__ __forceinline__ void glds16(const void* gsrc, unsigned lds_dst) { unsigned keep;
    asm volatile("s_mov_b32 %0, m0\n\ts_mov_b32 m0, %2\n\ts_nop 0\n\tglobal_load_lds_dwordx4 %1, off\n\ts_mov_b32 m0, %0" : "=&s"(keep) : "v"(gsrc), "s"(lds_dst) : "memory"); }
__device__ __forceinline__ float rowmax32(const f32x16& p0, const f32x16& p1) {
    float a = fmaxf(p0[0], p1[0]);
#pragma unroll
    for (int r = 1; r < 16; ++r) a = fmaxf(a, fmaxf(p0[r], p1[r]));
    auto rr = __builtin_amdgcn_permlane32_swap(__float_as_uint(a), __float_as_uint(a), false, false);
    return fmaxf(__uint_as_float(rr[0]), __uint_as_float(rr[1]));
}
__device__ __forceinline__ float swap_other(float v, int hi) {
    auto rr = __builtin_amdgcn_permlane32_swap(__float_as_uint(v), __float_as_uint(v), false, false);
    return __uint_as_float(hi ? rr[0] : rr[1]);
}
__device__ __forceinline__ unsigned swap_other_u(unsigned v, int hi) {
    auto rr = __builtin_amdgcn_permlane32_swap(v, v, false, false);
    return hi ? rr[0] : rr[1];
}
template <int NK>
__device__ __forceinline__ void qkt(f32x16& p0, f32x16& p1, const LAS unsigned char* Kslot, const bf16x8* qr, float cinit, int r32, int hi) {
    unsigned kbu = (unsigned)(uintptr_t)(Kslot + hi * 1024 + r32 * 16); OPAQUE(kbu); const LAS unsigned char* kb = (const LAS unsigned char*)kbu;
    f32x16 c;
#pragma unroll
    for (int r = 0; r < 16; ++r) c[r] = cinit;
    p0 = c; p1 = c;
#pragma unroll
    for (int d0 = 0; d0 < NK; ++d0) {
        const bf16x8 b0 = *(const LAS bf16x8*)(kb + d0 * 2048);
        const bf16x8 b1 = *(const LAS bf16x8*)(kb + d0 * 2048 + 512);
        p0 = __builtin_amdgcn_mfma_f32_32x32x16_bf16(b0, qr[d0], p0, 0, 0, 0);
        p1 = __builtin_amdgcn_mfma_f32_32x32x16_bf16(b1, qr[d0], p1, 0, 0, 0);
    }
}
__device__ __forceinline__ void pv(f32x16* o, unsigned vb, bf16x8 pa0, bf16x8 pa1, bf16x8 pa2, bf16x8 pa3) {
#pragma unroll
    for (int d0 = 0; d0 < 2; ++d0) { s16x4 lo[4], hi[4];
#pragma unroll
        for (int ks = 0; ks < 4; ++ks) {
            asm volatile("ds_read_b64_tr_b16 %0,%1 offset:%c2" : "=&v"(lo[ks]) : "v"(vb), "i"(d0 * 4096 + ks * 1024) : "memory");
            asm volatile("ds_read_b64_tr_b16 %0,%1 offset:%c2" : "=&v"(hi[ks]) : "v"(vb), "i"(d0 * 4096 + ks * 1024 + 512) : "memory"); }
        asm volatile("s_waitcnt lgkmcnt(0)" ::: "memory"); SBAR();
#define PK(k) (bf16x8){lo[k][0], lo[k][1], lo[k][2], lo[k][3], hi[k][0], hi[k][1], hi[k][2], hi[k][3]}
        o[d0] = __builtin_amdgcn_mfma_f32_32x32x16_bf16(pa0, PK(0), o[d0], 0, 0, 0);
        o[d0] = __builtin_amdgcn_mfma_f32_32x32x16_bf16(pa1, PK(1), o[d0], 0, 0, 0);
        o[d0] = __builtin_amdgcn_mfma_f32_32x32x16_bf16(pa2, PK(2), o[d0], 0, 0, 0);
        o[d0] = __builtin_amdgcn_mfma_f32_32x32x16_bf16(pa3, PK(3), o[d0], 0, 0, 0);
#undef PK
    }
}
__device__ __forceinline__ float softmax_pv(f32x16& p0, f32x16& p1, float& mhat, float& l, f32x16* o, volatile LAS float* wsf, unsigned vb, int r32, int hi) {
    const float rm = rowmax32(p0, p1);
    float f = 1.0f;
    if (__any(rm > 0.f)) {
        const float dl = fmaxf(rm, 0.f); mhat += dl;
#pragma unroll
        for (int r = 0; r < 16; ++r) { p0[r] -= dl; p1[r] -= dl; }
        f = __builtin_amdgcn_exp2f(-dl); l *= f;
        if (hi == 0) wsf[r32] = f;
        LDS_WAIT();
        { unsigned wb = (unsigned)(uintptr_t)(wsf + 4 * hi); OPAQUE(wb); volatile LAS float* wq = (volatile LAS float*)wb;
#pragma unroll
        for (int r = 0; r < 16; ++r) { const float ff = wq[(r & 3) + 8 * (r >> 2)]; o[0][r] *= ff; o[1][r] *= ff; } }
    }
    float s = 0.f;
#pragma unroll
    for (int r = 0; r < 16; ++r) { p0[r] = __builtin_amdgcn_exp2f(p0[r]); p1[r] = __builtin_amdgcn_exp2f(p1[r]); s += p0[r] + p1[r]; }
    l += s;
    u32x4 w0, w1, w2, w3;
    w0 = (u32x4){cvtpk(p0[0], p0[1]), cvtpk(p0[2], p0[3]), cvtpk(p0[4], p0[5]), cvtpk(p0[6], p0[7])};
    w1 = (u32x4){cvtpk(p0[8], p0[9]), cvtpk(p0[10], p0[11]), cvtpk(p0[12], p0[13]), cvtpk(p0[14], p0[15])};
    w2 = (u32x4){cvtpk(p1[0], p1[1]), cvtpk(p1[2], p1[3]), cvtpk(p1[4], p1[5]), cvtpk(p1[6], p1[7])};
    w3 = (u32x4){cvtpk(p1[8], p1[9]), cvtpk(p1[10], p1[11]), cvtpk(p1[12], p1[13]), cvtpk(p1[14], p1[15])};
    pv(o, vb, __builtin_bit_cast(bf16x8, w0), __builtin_bit_cast(bf16x8, w1), __builtin_bit_cast(bf16x8, w2), __builtin_bit_cast(bf16x8, w3));
    return f;
}
__device__ __forceinline__ void lut_bias(f32x16& p0, f32x16& p1, const LAS float* lut, int d0, int hi) {
    const LAS float* lp = lut + (d0 - 4 * hi - 63);
#pragma unroll
    for (int r = 0; r < 16; ++r) { const int ko = (r & 3) + 8 * (r >> 2);
        p0[r] += lp[63 - ko]; p1[r] += lp[63 - ko - 32]; }
}
__device__ __forceinline__ void lut_bias_cmp(f32x16& p0, f32x16& p1, const LAS float* lut, int d0, int hi) {
#pragma unroll
    for (int r = 0; r < 16; ++r) { const int ko = (r & 3) + 8 * (r >> 2) + 4 * hi;
        int n0 = d0 - 16 * ko, n1 = n0 - 512;
        n0 = n0 < -1 ? -1 : (n0 > 128 ? 128 : n0); n1 = n1 < -1 ? -1 : (n1 > 128 ? 128 : n1);
        p0[r] += lut[n0]; p1[r] += lut[n1]; }
}
__device__ __forceinline__ void cmask(f32x16& p0, f32x16& p1, int jb, int qrel, int hi) {
    const int kb = 64 * jb + 4 * hi;
#pragma unroll
    for (int r = 0; r < 16; ++r) { const int kv = kb + (r & 3) + 8 * (r >> 2); if (kv > qrel) p0[r] = NEGBIG; if (kv + 32 > qrel) p1[r] = NEGBIG; }
}
#define WAIT_BAR0() asm volatile("s_waitcnt vmcnt(0) lgkmcnt(0)\n\ts_barrier" ::: "memory")

__device__ __forceinline__ void fox_unit(const Frame& F, const Args& a, int b, int h, int qb) {
    const int lane = F.lane, r32 = lane & 31, hi = lane >> 5, wid = F.wave;
    const unsigned lds0 = (unsigned)(uintptr_t)F.lds;
    const bf16_t* FQ = (const bf16_t*)(a.ws + WS_FQ); const bf16_t* FK = (const bf16_t*)(a.ws + WS_FK); const bf16_t* FV = (const bf16_t*)(a.ws + WS_FV);
    const bf16_t* FB = (const bf16_t*)(a.ws + WS_FB) + (size_t)(b * 8 + h) * T * 16;
    bf16_t* O = (bf16_t*)(a.ws + WS_OFOX);
    const long rowbase = (long)b * T; const int q0 = qb * 256;
    const bf16_t* Kh = FK + rowbase * 512 + h * 64; const bf16_t* Vh = FV + rowbase * 512 + h * 64;
    const bf16_t* ksrc = Kh + (long)lane * 512 + wid * 8;
    const bf16_t* vsrc = Vh + (long)(16 * (wid & 3) + (lane >> 2)) * 512 + (wid >> 2) * 32 + (lane & 3) * 8;
    const bf16_t* fsrc = FB + (long)lane * 16 + (wid & 1) * 8;
    const unsigned kdst = lds0 + L_K + wid * 1024, vdst = lds0 + L_V + wid * 1024, fdst = lds0 + L_K + 8192 + (wid & 1) * 1024;
#define FOX_DMA(t, s) do { glds16(ksrc + (long)(t) * 64 * 512, (unsigned)__builtin_amdgcn_readfirstlane(kdst + (s) * KSLOT)); glds16(vsrc + (long)(t) * 64 * 512, (unsigned)__builtin_amdgcn_readfirstlane(vdst + (s) * VSLOT)); \
        if (wid < 2) glds16(fsrc + (long)(t) * 64 * 16, (unsigned)__builtin_amdgcn_readfirstlane(fdst + (s) * KSLOT)); } while (0)
    const unsigned vb0 = lds0 + L_V + ((lane >> 4) & 1) * 32 + (lane & 3) * 8 + (4 * hi + ((lane & 15) >> 2)) * 64;
    volatile LAS float* wsf = (volatile LAS float*)(F.lds + L_WSF) + wid * 64;
    const int NT = (q0 + 256) / 64;
    __syncthreads();
    FOX_DMA(0, 0);
    bf16x8 qr[5];
    { const bf16_t* Qw = FQ + (rowbase + q0 + wid * 32 + r32) * 512 + h * 64;
#pragma unroll
      for (int d0 = 0; d0 < 4; ++d0) qr[d0] = *(const bf16x8*)(Qw + d0 * 16 + hi * 8);
      const short one = (short)0x3f80; qr[4] = hi ? (bf16x8){0, 0, 0, 0, 0, 0, 0, 0} : (bf16x8){one, one, one, 0, 0, 0, 0, 0}; }
    float mhat = -100.f, l = 0.f; f32x16 o[2]; o[0] = f32x16{}; o[1] = f32x16{};
    const int qrel = wid * 32 + r32;
#pragma unroll 1
    for (int t = 0; t < NT; ++t) {
        WAIT_BAR0();
        if (t + 1 < NT) FOX_DMA(t + 1, (t + 1) & 1);
        f32x16 p0, p1;
        qkt<5>(p0, p1, F.lds + L_K + (t & 1) * KSLOT, qr, -mhat, r32, hi);
        const int jb = t - (NT - 4); if (jb >= 0) cmask(p0, p1, jb, qrel, hi);
        softmax_pv(p0, p1, mhat, l, o, wsf, vb0 + (t & 1) * VSLOT, r32, hi);
    }
    l += swap_other(l, hi);
    if (hi == 0) wsf[32 + r32] = l; LDS_WAIT();
    LAS bf16_t* st = (LAS bf16_t*)(F.lds + L_OST) + wid * 2048;
#pragma unroll
    for (int r = 0; r < 16; ++r) { const int orow = crow(r, hi); const float rl = __builtin_amdgcn_rcpf(wsf[32 + orow]);
#pragma unroll
        for (int d0 = 0; d0 < 2; ++d0) { const unsigned w = cvtpk(o[d0][r] * rl, 0.f); st[orow * 64 + d0 * 32 + r32] = (bf16_t)(w & 0xffffu); } }
    LDS_WAIT();
    bf16_t* Ow = O + (rowbase + q0 + wid * 32) * 512 + h * 64;
#pragma unroll
    for (int i = 0; i < 4; ++i) { const int row = i * 8 + (lane >> 3), ch = lane & 7; const u32x4 v = *(const LAS u32x4*)(st + row * 64 + ch * 8); *(u32x4*)(Ow + (long)row * 512 + ch * 8) = v; }
#undef FOX_DMA
}

__device__ __forceinline__ void nsa_unit(const Frame& F, const Args& a, int bg, int qb) {
    const int wid = F.wave;
    const int b = bg >> 1, g = bg & 1, q0 = qb * 64;
#define NSA_CTX() int lane = F.lane; OPAQUE(lane); const int r32 = lane & 31, hi = lane >> 5; \
    const unsigned lds0 = (unsigned)(uintptr_t)F.lds; \
    const int tok = r32 & 7, hh = r32 >> 3, h = g * 4 + hh, qpos = q0 + 8 * wid + tok; (void)h; (void)qpos; \
    const int koff = lane * 64 + wid * 8, voff = (16 * (wid & 3) + (lane >> 2)) * 64 + (wid >> 2) * 32 + (lane & 3) * 8; (void)koff; (void)voff; \
    const unsigned kdst = lds0 + L_K + wid * 1024, vdst = lds0 + L_V + wid * 1024; (void)kdst; (void)vdst; \
    const unsigned vb0 = lds0 + L_V + ((lane >> 4) & 1) * 32 + (lane & 3) * 8 + (4 * hi + ((lane & 15) >> 2)) * 64; (void)vb0; \
    volatile LAS float* wsf = (volatile LAS float*)(F.lds + L_WSF) + wid * 64; (void)wsf; \
    LAS float* ost = (LAS float*)(F.lds + L_OST) + wid * 2048; (void)ost; \
    const LAS float* lut = (const LAS float*)(F.lds + L_LUT) + hh * 384 + 64; (void)lut
#define NSA_DMA(Kp, Vp, t, s) do { glds16((Kp) + (size_t)(t) * 4096 + koff, (unsigned)__builtin_amdgcn_readfirstlane(kdst + (s) * KSLOT)); glds16((Vp) + (size_t)(t) * 4096 + voff, (unsigned)__builtin_amdgcn_readfirstlane(vdst + (s) * VSLOT)); } while (0)
#define BR_BEGIN() do { mhat = -100.f; l = 0.f; o[0] = f32x16{}; o[1] = f32x16{}; } while (0)
#define BR_END(gate, FIRST) do { l += swap_other(l, hi); const float fac = (l > 0.f) ? (gate) * __builtin_amdgcn_rcpf(l) : 0.f; \
        if (hi == 0) wsf[r32] = fac; LDS_WAIT(); \
        unsigned wb_ = (unsigned)(uintptr_t)(wsf + 4 * hi), ob_ = (unsigned)(uintptr_t)(ost + 4 * hi * 64 + r32); OPAQUE(wb_); OPAQUE(ob_); \
        volatile LAS float* wq_ = (volatile LAS float*)wb_; LAS float* oq_ = (LAS float*)ob_; \
        _Pragma("unroll") for (int r = 0; r < 16; ++r) { const float ff = wq_[(r & 3) + 8 * (r >> 2)]; LAS float* dst = oq_ + ((r & 3) + 8 * (r >> 2)) * 64; \
            if (FIRST) { dst[0] = o[0][r] * ff; dst[32] = o[1][r] * ff; } else { dst[0] += o[0][r] * ff; dst[32] += o[1][r] * ff; } } LDS_WAIT(); } while (0)
    const bf16_t* KV6 = (const bf16_t*)(a.ws + WS_KV6);
    __syncthreads();
    { const float* lg = (const float*)(a.ws + WS_LUT) + (size_t)g * 4 * 384; LAS float* lutl = (LAS float*)(F.lds + L_LUT); for (int i = F.tid; i < 4 * 384; i += 512) lutl[i] = lg[i]; }
    bf16x8 qr[4];
    float gate0, gate1, gate2, b31;
    { NSA_CTX();
      const size_t row = (size_t)b * T + qpos;
      const bf16_t* Qw = (const bf16_t*)(a.ws + WS_NQ) + row * 512 + h * 64;
#pragma unroll
      for (int d0 = 0; d0 < 4; ++d0) qr[d0] = *(const bf16x8*)(Qw + d0 * 16 + hi * 8);
      const float* gl = (const float*)(a.ws + WS_SMALL) + row * 32 + 8 + h * 3;
      gate0 = fsigmoid(gl[0]); gate1 = fsigmoid(gl[1]); gate2 = fsigmoid(gl[2]);
      b31 = ((const float*)(a.ws + WS_LUT))[(size_t)h * 384 + 64 + 128]; }
    float mhat, l; f32x16 o[2];

    unsigned long long selmask;
    {
        NSA_CTX();
        const bf16_t* KCp = (const bf16_t*)(a.ws + WS_KC) + (size_t)bg * 256 * 64; const bf16_t* VCp = KCp + (size_t)8 * 256 * 64;
        const int cmax = (q0 + 63 - 31) >> 4, ncmp = (cmax >> 6) + 1;
        float imp[32];
#pragma unroll
        for (int i = 0; i < 32; ++i) imp[i] = 0.f;
        float carry = 0.f;
        BR_BEGIN();
        __syncthreads();
        NSA_DMA(KCp, VCp, 0, 0);
#pragma unroll
        for (int i = 0; i < 4; ++i) {
            if (i < ncmp) {
                WAIT_BAR0();
                if (i + 1 < ncmp) NSA_DMA(KCp, VCp, i + 1, (i + 1) & 1);
                f32x16 p0, p1;
                qkt<4>(p0, p1, F.lds + L_K + (i & 1) * KSLOT, qr, -mhat, r32, hi);
                lut_bias_cmp(p0, p1, lut, qpos - 31 - 1024 * i, hi);
                const float f = softmax_pv(p0, p1, mhat, l, o, wsf, vb0 + (i & 1) * VSLOT, r32, hi);
#pragma unroll
                for (int k = 0; k < 8 * i; ++k) imp[k] *= f;
                carry *= f;
                float e3[8];
#pragma unroll
                for (int k = 0; k < 8; ++k) { const f32x16& pp = (k < 4) ? p0 : p1; const int rb = 4 * (k & 3);
                    imp[8 * i + k] = (pp[rb] + pp[rb + 1]) + (pp[rb + 2] + pp[rb + 3]); e3[k] = pp[rb + 3]; }
                float pe3[8];
#pragma unroll
                for (int k = 0; k < 8; ++k) pe3[k] = swap_other(e3[k], hi);
#pragma unroll
                for (int k = 0; k < 8; ++k) imp[8 * i + k] += hi ? pe3[k] : (k == 0 ? carry : pe3[k - 1]);
                carry = pe3[7];
            }
        }
        BR_END(gate0, true);
        const float rl = (l > 0.f) ? __builtin_amdgcn_rcpf(l) : 0.f;
        const int cur = qpos >> 6;
        unsigned key[32];
#pragma unroll
        for (int i = 0; i < 32; ++i) { float v = imp[i] * rl; v += __shfl_xor(v, 8); v += __shfl_xor(v, 16);
            const int s = 16 * (i >> 3) + 2 * (i & 7) + hi;
            unsigned kbits = (__float_as_uint(v) & ~63u) | (unsigned)(63 - s);
            if (s == 0 || s == cur || s == cur - 1) kbits = 0x7f000000u | (unsigned)(63 - s);
            if (s > cur) kbits = 0u;
            key[i] = kbits; }
        unsigned long long msk = 0ull;
#pragma unroll 1
        for (int pass = 0; pass < 16; ++pass) {
            unsigned mx = key[0];
#pragma unroll
            for (int i = 1; i < 32; ++i) mx = mx > key[i] ? mx : key[i];
            const unsigned om = swap_other_u(mx, hi); mx = mx > om ? mx : om;
            if (mx != 0u) msk |= 1ull << (63 - (int)(mx & 63u));
#pragma unroll
            for (int i = 0; i < 32; ++i) key[i] = (key[i] == mx) ? 0u : key[i];
        }
        selmask = msk;
    }
#ifndef NO_SEL
    {
        NSA_CTX();
        const bf16_t* KSL = KV6 + 2 * KV6_ELEMS + (size_t)bg * T * 64; const bf16_t* VSL = KV6 + 3 * KV6_ELEMS + (size_t)bg * T * 64;
        BR_BEGIN();
        const int nt = qb + 1;
        __syncthreads();
        NSA_DMA(KSL, VSL, 0, 0);
#pragma unroll 1
        for (int t = 0; t < nt; ++t) {
            WAIT_BAR0();
            if (t + 1 < nt) NSA_DMA(KSL, VSL, t + 1, (t + 1) & 1);
            const bool sel = (selmask >> t) & 1ull;
            const bool band = (t >= qb - 2);
            f32x16 p0, p1;
            qkt<4>(p0, p1, F.lds + L_K + (t & 1) * KSLOT, qr, sel ? (band ? -mhat : b31 - mhat) : NEGBIG, r32, hi);
            if (band) lut_bias(p0, p1, lut, qpos - 64 * t, hi);
            softmax_pv(p0, p1, mhat, l, o, wsf, vb0 + (t & 1) * VSLOT, r32, hi);
        }
        BR_END(gate1, false);
    }
#endif
#ifndef NO_WIN
    {
        NSA_CTX();
        const bf16_t* KWN = KV6 + 4 * KV6_ELEMS + (size_t)bg * T * 64; const bf16_t* VWN = KV6 + 5 * KV6_ELEMS + (size_t)bg * T * 64;
        const LAS float* lutw = lut - 64 + 256 - 448;
        BR_BEGIN();
        const int t0 = qb >= 8 ? qb - 8 : 0, nt = qb - t0 + 1;
        __syncthreads();
        NSA_DMA(KWN, VWN, t0, 0);
#pragma unroll 1
        for (int i = 0; i < nt; ++i) {
            const int t = t0 + i;
            WAIT_BAR0();
            if (i + 1 < nt) NSA_DMA(KWN, VWN, t + 1, (i + 1) & 1);
            const bool band = (t >= qb - 2), far = (t == qb - 8);
            f32x16 p0, p1;
            qkt<4>(p0, p1, F.lds + L_K + (i & 1) * KSLOT, qr, (band || far) ? -mhat : b31 - mhat, r32, hi);
            if (band) lut_bias(p0, p1, lut, qpos - 64 * t, hi);
            else if (far) lut_bias(p0, p1, lutw, qpos - 64 * t, hi);
            softmax_pv(p0, p1, mhat, l, o, wsf, vb0 + (i & 1) * VSLOT, r32, hi);
        }
        BR_END(gate2, false);
    }
#endif
    {
        NSA_CTX();
        bf16_t* O = (bf16_t*)(a.ws + WS_ONSA);
#pragma unroll
        for (int i = 0; i < 4; ++i) { const int rr = i * 8 + (lane >> 3), ch = lane & 7; const LAS f32x4* sp = (const LAS f32x4*)(ost + rr * 64 + ch * 8); const f32x4 v0 = sp[0], v1 = sp[1];
            const int tk = rr & 7, h2 = g * 4 + (rr >> 3);
            *(u32x4*)(O + ((size_t)b * T + q0 + 8 * wid + tk) * 512 + h2 * 64 + ch * 8) = pg8::pack8(v0, v1); }
    }
#undef NSA_CTX
#undef NSA_DMA
#undef BR_BEGIN
#undef BR_END
}

__global__ void __launch_bounds__(NWAVES * 64, 2) fwd_kernel(Args a) {
    extern __shared__ __attribute__((aligned(16))) unsigned char lds_raw[];
    cg::grid_group grid = cg::this_grid();
    Frame F; F.lds = (LAS unsigned char*)lds_raw; F.tid = threadIdx.x; F.lane = F.tid & 63; F.wave = __builtin_amdgcn_readfirstlane(F.tid >> 6); F.G = gridDim.x; F.bid = blockIdx.x;
    unsigned char* ws = a.ws;
    const int lo = a.ph_lo, hi = a.ph_hi;
#ifndef PH_MASK
#define PH_MASK 0x1ff
#endif
#define IN(k) (((PH_MASK >> (k)) & 1) && lo <= (k) && (k) < hi)
#define SEAM(k) do { if (IN(k) && IN((k) + 1)) grid.sync(); } while (0)
    if (IN(0)) { p0_prologue(F, a); } SEAM(0);
    if (IN(1)) {
        pg8::Gemm g{(const bf16_t*)(ws + WS_XN), nullptr, (const bf16_t*)(ws + WS_WIN), nullptr, M, NIN, D};
        pg8::StaticOrder S; S.init(M, NIN, F.G, F.bid, 0);
        pg8::EpiQKV E{(bf16_t*)(ws + WS_FQ), (bf16_t*)(ws + WS_FK), (bf16_t*)(ws + WS_FV), (bf16_t*)(ws + WS_NQ), (bf16_t*)(ws + WS_KV6), (bf16_t*)(ws + WS_GA), (bf16_t*)(ws + WS_GB), (float*)(ws + WS_SMALL)};
        pg8::gemm_phase<pg8::EpiQKV, true, true>(F.lds, g, S, E);
    } SEAM(1);
    if (IN(2)) {
        for (int u = F.bid; u < 64; u += F.G) compress_unit(F, a, u);
        for (int s = 0; s < 32; ++s) if (((s + 64) % F.G) == F.bid && F.wave == 0) scan_seq(a, s, F.lane);
    } SEAM(2);
    if (IN(3)) {
        for (int v = F.bid; v < 256; v += F.G) {
#ifndef NO_FOX
            { const int bh = v >> 3, s = v & 7; for (int k = 0; k < 2; ++k) fox_unit(F, a, bh >> 3, bh & 7, k ? 15 - s : s); }
#endif
#ifndef NO_NSA
            { const int bg = v >> 5, s = v & 31; for (int k = 0; k < 2; ++k) nsa_unit(F, a, bg, k ? 63 - s : s); }
#endif
        }
        __syncthreads();
    } SEAM(3);
    if (IN(4)) {
        pg8::Gemm g{(const bf16_t*)(ws + WS_OFOX), (const bf16_t*)(ws + WS_ONSA), (const bf16_t*)(ws + WS_WF), (const bf16_t*)(ws + WS_WN), M, D, 512};
        pg8::StaticOrder S; S.init(M, D, F.G, F.bid, 1);
        pg8::EpiMerge E{(const bf16_t*)(ws + WS_GA), (const bf16_t*)(ws + WS_GB), (bf16_t*)(ws + WS_MERGED)};
        pg8::gemm_phase<pg8::EpiMerge, true, true>(F.lds, g, S, E);
    } SEAM(4);
    if (IN(5)) {
        pg8::Gemm g{(const bf16_t*)(ws + WS_MERGED), nullptr, (const bf16_t*)(ws + WS_WOUT), nullptr, M, D, D};
        pg8::StaticOrder S; S.init(M, D, F.G, F.bid, 0);
        pg8::EpiRes E{a.x, a.out, (bf16_t*)(ws + WS_XN), (float*)(ws + WS_SSQ1)};
        pg8::gemm_phase<pg8::EpiRes, true, true>(F.lds, g, S, E);
    } SEAM(5);
    if (IN(6)) {
        pg8::Gemm g{(const bf16_t*)(ws + WS_XN), nullptr, (const bf16_t*)(ws + WS_W1), nullptr, M, FF, D};
        pg8::StaticOrder S; S.init(M, FF, F.G, F.bid, 0);
        pg8::EpiFF1 E{(const float*)(ws + WS_SSQ1), (bf16_t*)(ws + WS_H)};
        pg8::gemm_phase<pg8::EpiFF1, true, true>(F.lds, g, S, E);
    } SEAM(6);
    if (IN(7)) {
        pg8::Gemm g{(const bf16_t*)(ws + WS_H), nullptr, (const bf16_t*)(ws + WS_W2), nullptr, M, D, FF};
        pg8::StaticOrder S; S.init(M, D, F.G, F.bid, 0);
        pg8::EpiRes E{a.out, a.out, nullptr, (float*)(ws + WS_SSQ2)};
        pg8::gemm_phase<pg8::EpiRes, true, true>(F.lds, g, S, E);
    } SEAM(7);
    if (IN(8)) {
        const int gw = F.bid * NWAVES + F.wave, NGW = F.G * NWAVES;
        const f32x4* gp = (const f32x4*)a.g_final + F.lane; f32x4 gv[4];
#pragma unroll
        for (int j = 0; j < 4; ++j) gv[j] = gp[64 * j];
        for (int m = gw; m < M; m += NGW) {
            const f32x4* sp = (const f32x4*)((const float*)(ws + WS_SSQ2) + (size_t)m * 16); const f32x4 s = (sp[0] + sp[1]) + (sp[2] + sp[3]);
            const float rstd = 1.0f / sqrtf(((s[0] + s[1]) + (s[2] + s[3])) * (1.0f / D) + RMS_EPS);
            f32x4* xr = (f32x4*)(a.out + (size_t)m * D) + F.lane;
#pragma unroll
            for (int j = 0; j < 4; ++j) xr[64 * j] = xr[64 * j] * rstd * gv[j];
        }
    }
#undef IN
#undef SEAM
}

#ifndef N_LAUNCHES
#define N_LAUNCHES 1
#endif
extern "C" void kernel_launch(void* const* d_in, const int* in_sizes, int n_in, void* d_out, int out_size, void* d_ws, size_t ws_size, hipStream_t stream) {
    static int grid = 0;
    if (grid == 0) {
        if (n_in != 18 || in_sizes[0] != M * D || out_size != M * D || ws_size < WS_END) { fprintf(stderr, "kernel_launch: unexpected shapes (n_in %d, in0 %d, out %d, ws %zu)\n", n_in, n_in > 0 ? in_sizes[0] : -1, out_size, ws_size); grid = -1; return; }
        int dev = 0, cus = 0, per_cu = 0;
        if (hipGetDevice(&dev) != hipSuccess || hipDeviceGetAttribute(&cus, hipDeviceAttributeMultiprocessorCount, dev) != hipSuccess) { grid = -1; return; }
        if (hipFuncSetAttribute((const void*)fwd_kernel, hipFuncAttributeMaxDynamicSharedMemorySize, LDS_BYTES) != hipSuccess) { fprintf(stderr, "hipFuncSetAttribute failed\n"); grid = -1; return; }
        if (hipOccupancyMaxActiveBlocksPerMultiprocessor(&per_cu, (const void*)fwd_kernel, NWAVES * 64, LDS_BYTES) != hipSuccess || per_cu < 1) { fprintf(stderr, "occupancy query: %d blocks/CU\n", per_cu); grid = -1; (void)hipGetLastError(); return; }
        grid = cus;
    }
    if (grid < 0) return;
    (void)hipMemsetAsync((char*)d_ws + WS_CTL, 0, CTL_ZERO_BYTES, stream);
    Args a{};
    const float** p = (const float**)&a;
    for (int i = 0; i < 18; ++i) p[i] = (const float*)d_in[i];
    a.out = (float*)d_out; a.ws = (unsigned char*)d_ws;
    constexpr int NPH = 9;
    for (int li = 0; li < N_LAUNCHES; ++li) {
        a.ph_lo = (N_LAUNCHES == 1) ? 0 : li; a.ph_hi = (N_LAUNCHES == 1) ? NPH : li + 1;
        void* args[] = {&a};
        hipError_t e = hipLaunchCooperativeKernel((void*)fwd_kernel, dim3(grid), dim3(NWAVES * 64), args, LDS_BYTES, stream);
        if (e != hipSuccess) { fprintf(stderr, "cooperative launch failed: %s (grid %d)\n", hipGetErrorString(e), grid); break; }
    }
}
```

```cpp
#include <hip/hip_runtime.h>
#include <hip/hip_cooperative_groups.h>
#include <hip/hip_bf16.h>
#include <cstdio>
#include <cstdint>
#include <cmath>
namespace cg = cooperative_groups;

#define LAS __attribute__((address_space(3)))
#define GAS __attribute__((address_space(1)))
typedef unsigned short bf16_t;
typedef short bf16x8 __attribute__((ext_vector_type(8)));
typedef short s16x4 __attribute__((ext_vector_type(4)));
typedef float f32x4 __attribute__((ext_vector_type(4)));
typedef float f32x2 __attribute__((ext_vector_type(2)));
typedef float f32x16 __attribute__((ext_vector_type(16)));
typedef unsigned u32x4 __attribute__((ext_vector_type(4)));
typedef unsigned u32x2 __attribute__((ext_vector_type(2)));
typedef __bf16 bf16x2_t __attribute__((ext_vector_type(2)));

constexpr int BATCH = 4, T = 4096, D = 1024, M = BATCH * T, FF = 4096;
constexpr int NIN = 5120;
constexpr int NKV = 2, NH = 8, HD = 64;
constexpr float RMS_EPS = 1e-6f;
constexpr float LOG2E = 1.4426950408889634f;
constexpr float C2 = 0.125f * LOG2E;
constexpr float NEGBIG = -1.0e30f;
constexpr int NWAVES = 8;

constexpr size_t MiB = 1u << 20;
constexpr size_t WS_CTL = 0, CTL_ZERO_BYTES = 64 * 1024;
constexpr size_t WS_BAR = 16384;
constexpr size_t WS_CB1 = 4096;
constexpr size_t WS_LUT = 1 * MiB;
constexpr size_t WS_CW2T = 1 * MiB + 64 * 1024;
constexpr size_t WS_SSQ1 = 2 * MiB, WS_SSQ2 = 3 * MiB;
constexpr size_t WS_WIN = 4 * MiB;
constexpr size_t WS_WF = 14 * MiB, WS_WN = 15 * MiB;
constexpr size_t WS_WOUT = 16 * MiB;
constexpr size_t WS_W1 = 18 * MiB, WS_W2 = 26 * MiB;
constexpr size_t WS_CW1 = 34 * MiB;
constexpr size_t WS_KC = 36 * MiB;
constexpr size_t WS_FB = 37 * MiB;
constexpr size_t WS_SMALL = 41 * MiB;
constexpr size_t WS_XN = 44 * MiB;
constexpr size_t WS_OFOX = 44 * MiB, WS_ONSA = 60 * MiB;
constexpr size_t WS_FQ = 76 * MiB, WS_FK = 92 * MiB, WS_FV = 108 * MiB, WS_NQ = 124 * MiB;
constexpr size_t WS_KV6 = 140 * MiB;
constexpr size_t KV6_ELEMS = (size_t)BATCH * NKV * T * HD;
constexpr size_t WS_GA = 165 * MiB, WS_GB = 197 * MiB;
constexpr size_t WS_MERGED = 76 * MiB;
constexpr size_t WS_H = 76 * MiB;
constexpr size_t WS_END = 229 * MiB;

constexpr int LDS_BYTES = 147456;
constexpr int KSLOT = 10240, VSLOT = 8192;
constexpr int L_K = 0, L_V = 2 * KSLOT, L_WSF = L_V + 2 * VSLOT, L_OST = L_WSF + 2048, L_LUT = L_OST + 8 * 8192, L_ATT_END = L_LUT + 4 * 384 * 4;
static_assert(L_ATT_END <= 131072, "attention LDS");
constexpr int L_MISC = 131072;

__device__ __forceinline__ unsigned cvtpk(float lo, float hi) { f32x2 v = {lo, hi}; bf16x2_t b = __builtin_convertvector(v, bf16x2_t); return __builtin_bit_cast(unsigned, b); }
__device__ __forceinline__ float bf_lo(unsigned w) { return __uint_as_float(w << 16); }
__device__ __forceinline__ float bf_hi(unsigned w) { return __uint_as_float(w & 0xffff0000u); }
__device__ __forceinline__ float fsigmoid(float x) { return __builtin_amdgcn_rcpf(1.0f + __builtin_amdgcn_exp2f(-x * LOG2E)); }
__device__ __forceinline__ int crow(int r, int hi) { return (r & 3) + 8 * (r >> 2) + 4 * hi; }
#define SBAR() __builtin_amdgcn_sched_barrier(0)
#define OPAQUE(x) asm volatile("" : "+v"(x))
#define LDS_WAIT() asm volatile("s_waitcnt lgkmcnt(0)" ::: "memory")
#define VM_WAIT() asm volatile("s_waitcnt vmcnt(0)" ::: "memory")

namespace pg8 {
constexpr int BM = 256, BK = 64, HALF = 128, HTB = HALF * BK * 2, STAGE_BYTES = 8 * HTB, NXCD = 8, WGM = 8;
__host__ __device__ __forceinline__ int lds_byte(int r, int c) { const int st = (r >> 4) * 2 + (c >> 5), rr = r & 15, cc = c & 31, ob = rr * 64 + cc * 2; return st * 1024 + (ob ^ (((ob >> 9) & 1) << 5)); }
__host__ __device__ __forceinline__ void stage_rc(int b, int& R, int& C) { const int st = b / 1024, sb = b % 1024, swz = sb ^ (((sb >> 9) & 1) << 5); R = (st >> 1) * 16 + swz / 64; C = (st & 1) * 32 + (swz % 64) / 2; }
__host__ __device__ __forceinline__ int perm32(int rho) { const int n = rho >> 4, i = rho & 15; return 8 * (i >> 2) + 4 * n + (i & 3); }

struct Unit { int pm, pn, w; };
struct Gemm { const bf16_t* A0; const bf16_t* A1; const bf16_t* B0; const bf16_t* B1; int M, N, K; };

struct StaticOrder {
    int nM, nN, nwg, G, c, dual;
    __device__ void init(int M_, int N_, int G_, int c_, int dual_) { nM = M_ / BM; nN = N_ / BM; nwg = nM * nN; G = G_; c = c_; dual = dual_; }
    __device__ bool next(int i, Unit& u) const {
        const int ti = dual ? (i >> 1) : i; u.w = dual ? (i & 1) : 0;
        const long L = (long)ti * G + c; if (L >= nwg) return false;
        int wgid = (int)L; { const int q = nwg / NXCD, r = nwg % NXCD, xcd = wgid % NXCD, off = wgid / NXCD; wgid = (xcd < r ? xcd * (q + 1) : r * (q + 1) + (xcd - r) * q) + off; }
        const int nig = WGM * nN, gid = wgid / nig, fm = gid * WGM, gsz = (nM - fm) < WGM ? (nM - fm) : WGM;
        u.pm = fm + ((wgid % nig) % gsz); u.pn = (wgid % nig) / gsz; return true;
    }
};

typedef f32x4 Acc[2][2][4][2];

template <class Epi, bool ALIGN_EPI, bool SP2>
__device__ __forceinline__ void gemm_phase(LAS unsigned char* lds, const Gemm g, const StaticOrder& S, const Epi& E) {
    const int tid = threadIdx.x, wid = __builtin_amdgcn_readfirstlane(tid >> 6), lane = tid & 63, wr = wid >> 2, wc = wid & 3, fr = lane & 15, fq = lane >> 4;
    const int K = g.K, nt = K / BK;
    unsigned voffA[2], voffB[2];
#pragma unroll
    for (int i = 0; i < 2; ++i) { int R, C; stage_rc(tid * 16 + i * 8192, R, C); const int Rb = Epi::PERM ? ((R & ~31) + perm32(R & 31)) : R;
        voffA[i] = (unsigned)(R * K + C) * 2u; voffB[i] = (unsigned)(Rb * K + C) * 2u; }
    const size_t kstep = (size_t)(BK * 2);
    const size_t hstep = (size_t)HALF * K * 2;
    const size_t tstep = 2 * hstep;
    const unsigned ldsw = (unsigned)wid * 1024u;
    const int aoff = lds_byte(wr * 64 + fr, fq * 8), boff = lds_byte(wc * 32 + fr, fq * 8);
#define PG8_SA(b, h) (((b) * 2 + (h)) * HTB)
#define PG8_SB(b, h) ((4 + (b) * 2 + (h)) * HTB)
#define PG8_STAGE(bufoff, gbase, voff) do { _Pragma("unroll") for (int _i = 0; _i < 2; ++_i) \
        __builtin_amdgcn_global_load_lds((const unsigned*)((const char*)(gbase) + (voff)[_i]), (LAS unsigned*)(lds + (bufoff) + ldsw + _i * 8192), 16, 0, 0); } while (0)
#define PG8_LDA(dst, b, h) do { _Pragma("unroll") for (int m = 0; m < 4; ++m) _Pragma("unroll") for (int k = 0; k < 2; ++k) dst[m][k] = *(const LAS bf16x8*)(lds + PG8_SA(b, h) + aoff + m * 2048 + k * 1024); } while (0)
#define PG8_LDB(dst, b, h) do { _Pragma("unroll") for (int n = 0; n < 2; ++n) _Pragma("unroll") for (int k = 0; k < 2; ++k) dst[n][k] = *(const LAS bf16x8*)(lds + PG8_SB(b, h) + boff + n * 2048 + k * 1024); } while (0)
#define PG8_MMA(ai, bj, At, Bt) do { __builtin_amdgcn_s_setprio(1); _Pragma("unroll") for (int m = 0; m < 4; ++m) _Pragma("unroll") for (int n = 0; n < 2; ++n) _Pragma("unroll") for (int k = 0; k < 2; ++k) \
        acc[ai][bj][m][n] = __builtin_amdgcn_mfma_f32_16x16x32_bf16(Bt[n][k], At[m][k], acc[ai][bj][m][n], 0, 0, 0); __builtin_amdgcn_s_setprio(0); } while (0)
#define PG8_WAIT_V(n) asm volatile("s_waitcnt vmcnt(" #n ")" ::: "memory")
#define PG8_WAIT_L(n) asm volatile("s_waitcnt lgkmcnt(" #n ")" ::: "memory")
#define PG8_BAR __builtin_amdgcn_s_barrier()
#define PG8_SCHED __builtin_amdgcn_sched_barrier(0)
    Unit cur, nxt; int ui = 0;
    if (!S.next(0, cur)) return;
    Acc acc;
#pragma unroll
    for (int a = 0; a < 2; ++a)
#pragma unroll
        for (int b = 0; b < 2; ++b)
#pragma unroll
            for (int m = 0; m < 4; ++m)
#pragma unroll
                for (int n = 0; n < 2; ++n) acc[a][b][m][n] = (f32x4){0.f, 0.f, 0.f, 0.f};
    bf16x8 At[4][2], B0[2][2], B1[2][2];
    const char* cA = (const char*)(cur.w ? g.A1 : g.A0) + (size_t)cur.pm * tstep; const char* cB = (const char*)(cur.w ? g.B1 : g.B0) + (size_t)cur.pn * tstep;
    if constexpr (SP2) {
        PG8_STAGE(PG8_SB(0, 0), cB, voffB); PG8_STAGE(PG8_SB(0, 1), cB + hstep, voffB); PG8_STAGE(PG8_SA(0, 0), cA, voffA); PG8_STAGE(PG8_SA(0, 1), cA + hstep, voffA);
        if (wr == 1) PG8_BAR;
        PG8_WAIT_V(2); PG8_BAR;
        PG8_STAGE(PG8_SB(1, 0), cB + kstep, voffB); PG8_STAGE(PG8_SA(1, 0), cA + kstep, voffA); PG8_STAGE(PG8_SB(1, 1), cB + hstep + kstep, voffB);
        PG8_WAIT_V(6); PG8_BAR;
    } else {
        PG8_STAGE(PG8_SB(0, 0), cB, voffB); PG8_STAGE(PG8_SA(0, 0), cA, voffA); PG8_STAGE(PG8_SB(0, 1), cB + hstep, voffB); PG8_STAGE(PG8_SA(0, 1), cA + hstep, voffA);
        if (wr == 1) PG8_BAR;
        PG8_WAIT_V(4); PG8_BAR;
        PG8_STAGE(PG8_SB(1, 0), cB + kstep, voffB); PG8_STAGE(PG8_SA(1, 0), cA + kstep, voffA); PG8_STAGE(PG8_SB(1, 1), cB + hstep + kstep, voffB);
        PG8_WAIT_V(6); PG8_BAR;
    }
    for (;;) {
        const bool has_next = S.next(ui + 1, nxt);
        const char* nA = has_next ? (const char*)(nxt.w ? g.A1 : g.A0) + (size_t)nxt.pm * tstep : cA; const char* nB = has_next ? (const char*)(nxt.w ? g.B1 : g.B0) + (size_t)nxt.pn * tstep : cB;
        for (int t = 0; t < nt; t += 2) {
            const bool last = (t == nt - 2);
            const char* a1 = cA + (size_t)(t + 1) * kstep;
            const char* a2 = last ? nA : cA + (size_t)(t + 2) * kstep; const char* b2 = last ? nB : cB + (size_t)(t + 2) * kstep;
            const char* a3 = a2 + kstep; const char* b3 = b2 + kstep;
            if constexpr (SP2) {
            PG8_LDB(B0, 0, 0); PG8_LDB(B1, 0, 1); PG8_SCHED; PG8_LDA(At, 0, 0); PG8_STAGE(PG8_SA(1, 1), a1 + hstep, voffA);
            PG8_WAIT_V(8); PG8_WAIT_L(0); PG8_BAR; PG8_MMA(0, 0, At, B0); PG8_MMA(0, 1, At, B1); PG8_BAR; PG8_SCHED;
            PG8_LDA(At, 0, 1); PG8_STAGE(PG8_SB(0, 0), b2, voffB); PG8_STAGE(PG8_SB(0, 1), b2 + hstep, voffB); PG8_STAGE(PG8_SA(0, 0), a2, voffA);
            PG8_WAIT_V(8); PG8_WAIT_L(0); PG8_BAR; PG8_MMA(1, 0, At, B0); PG8_MMA(1, 1, At, B1); PG8_BAR; PG8_SCHED;
            PG8_LDB(B0, 1, 0); PG8_LDB(B1, 1, 1); PG8_SCHED; PG8_LDA(At, 1, 0); PG8_STAGE(PG8_SA(0, 1), a2 + hstep, voffA);
            PG8_WAIT_V(8); PG8_WAIT_L(0); PG8_BAR; PG8_MMA(0, 0, At, B0); PG8_MMA(0, 1, At, B1); PG8_BAR; PG8_SCHED;
            PG8_LDA(At, 1, 1); PG8_STAGE(PG8_SB(1, 0), b3, voffB); PG8_STAGE(PG8_SB(1, 1), b3 + hstep, voffB); PG8_STAGE(PG8_SA(1, 0), a3, voffA);
            PG8_WAIT_V(8); PG8_WAIT_L(0); PG8_BAR; PG8_MMA(1, 0, At, B0); PG8_MMA(1, 1, At, B1); PG8_BAR; PG8_SCHED;
            } else {
            PG8_LDB(B0, 0, 0); PG8_SCHED; PG8_LDA(At, 0, 0); PG8_STAGE(PG8_SA(1, 1), a1 + hstep, voffA);
            PG8_WAIT_L(8); PG8_BAR; PG8_WAIT_L(0); PG8_MMA(0, 0, At, B0); PG8_BAR; PG8_SCHED;
            PG8_LDB(B1, 0, 1); PG8_STAGE(PG8_SB(0, 0), b2, voffB);
            PG8_BAR; PG8_WAIT_L(0); PG8_MMA(0, 1, At, B1); PG8_BAR;
            PG8_LDA(At, 0, 1); PG8_STAGE(PG8_SA(0, 0), a2, voffA);
            PG8_BAR; PG8_WAIT_L(0); PG8_MMA(1, 0, At, B0); PG8_BAR; PG8_SCHED;
            PG8_STAGE(PG8_SB(0, 1), b2 + hstep, voffB);
            PG8_WAIT_V(6); PG8_BAR; PG8_MMA(1, 1, At, B1); PG8_BAR;
            PG8_LDB(B0, 1, 0); PG8_SCHED; PG8_LDA(At, 1, 0); PG8_STAGE(PG8_SA(0, 1), a2 + hstep, voffA);
            PG8_WAIT_L(8); PG8_BAR; PG8_WAIT_L(0); PG8_MMA(0, 0, At, B0); PG8_BAR; PG8_SCHED;
            PG8_LDB(B1, 1, 1); PG8_STAGE(PG8_SB(1, 0), b3, voffB);
            PG8_BAR; PG8_WAIT_L(0); PG8_MMA(0, 1, At, B1); PG8_BAR;
            PG8_LDA(At, 1, 1); PG8_STAGE(PG8_SA(1, 0), a3, voffA);
            PG8_BAR; PG8_WAIT_L(0); PG8_MMA(1, 0, At, B0); PG8_BAR; PG8_SCHED;
            PG8_STAGE(PG8_SB(1, 1), b3 + hstep, voffB);
            PG8_WAIT_V(6); PG8_BAR; PG8_MMA(1, 1, At, B1); PG8_BAR;
            }
        }
        if constexpr (ALIGN_EPI) { if (wr == 0) PG8_BAR; }
        const bool keep = Epi::DUAL && (cur.w == 0);
        if (keep) E.mid(acc, cur, wr, wc, fr, fq); else E(acc, cur, wr, wc, fr, fq);
        if (!has_next) break;
        if (!keep) {
#pragma unroll
        for (int a = 0; a < 2; ++a)
#pragma unroll
            for (int b = 0; b < 2; ++b)
#pragma unroll
                for (int m = 0; m < 4; ++m)
#pragma unroll
                    for (int n = 0; n < 2; ++n) acc[a][b][m][n] = (f32x4){0.f, 0.f, 0.f, 0.f};
        }
        cur = nxt; cA = nA; cB = nB; ++ui;
        if constexpr (ALIGN_EPI) { if (wr == 1) PG8_BAR; }
    }
    PG8_WAIT_V(0);
    if constexpr (!ALIGN_EPI) { if (wr == 0) PG8_BAR; }
    PG8_BAR;
#undef PG8_SA
#undef PG8_SB
#undef PG8_STAGE
#undef PG8_LDA
#undef PG8_LDB
#undef PG8_MMA
#undef PG8_WAIT_V
#undef PG8_WAIT_L
#undef PG8_BAR
#undef PG8_SCHED
}

__device__ __forceinline__ u32x4 pack8(f32x4 v0, f32x4 v1) { u32x4 w; w.x = cvtpk(v0[0], v0[1]); w.y = cvtpk(v0[2], v0[3]); w.z = cvtpk(v1[0], v1[1]); w.w = cvtpk(v1[2], v1[3]); return w; }

struct EpiQKV {
    static constexpr bool PERM = true, DUAL = false;
    bf16_t *FQ, *FK, *FV, *NQ, *KV6, *GA, *GB; float* SMALL;
    __device__ __forceinline__ void mid(Acc& acc, const Unit& u, int wr, int wc, int fr, int fq) const {}
    __device__ __forceinline__ void operator()(const Acc& acc, const Unit& u, int wr, int wc, int fr, int fq) const {
        const int pn = u.pn, row0 = u.pm * BM + wr * 64 + fr, cl = wc * 32 + 8 * fq;
#pragma unroll
        for (int ai = 0; ai < 2; ++ai)
#pragma unroll
            for (int m = 0; m < 4; ++m) { const int row = row0 + ai * HALF + m * 16;
#pragma unroll
                for (int bj = 0; bj < 2; ++bj) { f32x4 v0 = acc[ai][bj][m][0], v1 = acc[ai][bj][m][1]; const int c = bj * HALF + cl;
                    if (pn < 8) { bf16_t* base = FQ + (size_t)(pn >> 1) * (8u << 20); const float sc = (pn < 2 || pn >= 6) ? C2 : 1.f;
                        *(u32x4*)(base + (size_t)row * 512 + (pn & 1) * 256 + c) = pack8(v0 * sc, v1 * sc);
                    } else if (pn < 11) { const int n6 = (pn - 8) * 256 + c, which = n6 >> 7, gg = (n6 >> 6) & 1, d = n6 & 63, b = row >> 12, t = row & 4095;
                        *(u32x4*)(KV6 + (size_t)which * KV6_ELEMS + ((size_t)((b * 2 + gg) * T + t) * 64 + d)) = pack8(v0, v1);
                    } else if (pn < 19) { bf16_t* base = GA + (size_t)((pn - 11) >> 2) * (16u << 20); const int col = ((pn - 11) & 3) * 256 + c;
                        f32x4 s0, s1;
#pragma unroll
                        for (int e = 0; e < 4; ++e) { s0[e] = fsigmoid(v0[e]); s1[e] = fsigmoid(v1[e]); }
                        *(u32x4*)(base + (size_t)row * 1024 + col) = pack8(s0, s1);
                    } else { if (c < 32) { *(f32x4*)(SMALL + (size_t)row * 32 + c) = v0; *(f32x4*)(SMALL + (size_t)row * 32 + c + 4) = v1; } }
                } }
    }
};
struct EpiMerge {
    static constexpr bool PERM = true, DUAL = true;
    const bf16_t *GA, *GB; bf16_t* OUT;
    __device__ __forceinline__ void mid(Acc& acc, const Unit& u, int wr, int wc, int fr, int fq) const {
        const int row0 = u.pm * BM + wr * 64 + fr, col0 = u.pn * BM + wc * 32 + 8 * fq;
#pragma unroll
        for (int ai = 0; ai < 2; ++ai)
#pragma unroll
            for (int m = 0; m < 4; ++m) { const size_t ro = (size_t)(row0 + ai * HALF + m * 16) * 1024 + col0;
#pragma unroll
                for (int bj = 0; bj < 2; ++bj) { const u32x4 a = *(const u32x4*)(GA + ro + bj * HALF), b = *(const u32x4*)(GB + ro + bj * HALF);
                    f32x4 r0, r1;
                    r0[0] = bf_lo(a.x) * __builtin_amdgcn_rcpf(bf_lo(b.x)); r0[1] = bf_hi(a.x) * __builtin_amdgcn_rcpf(bf_hi(b.x));
                    r0[2] = bf_lo(a.y) * __builtin_amdgcn_rcpf(bf_lo(b.y)); r0[3] = bf_hi(a.y) * __builtin_amdgcn_rcpf(bf_hi(b.y));
                    r1[0] = bf_lo(a.z) * __builtin_amdgcn_rcpf(bf_lo(b.z)); r1[1] = bf_hi(a.z) * __builtin_amdgcn_rcpf(bf_hi(b.z));
                    r1[2] = bf_lo(a.w) * __builtin_amdgcn_rcpf(bf_lo(b.w)); r1[3] = bf_hi(a.w) * __builtin_amdgcn_rcpf(bf_hi(b.w));
                    acc[ai][bj][m][0] *= r0; acc[ai][bj][m][1] *= r1; } }
    }
    __device__ __forceinline__ void operator()(const Acc& acc, const Unit& u, int wr, int wc, int fr, int fq) const {
        const int row0 = u.pm * BM + wr * 64 + fr, col0 = u.pn * BM + wc * 32 + 8 * fq;
#pragma unroll
        for (int ai = 0; ai < 2; ++ai)
#pragma unroll
            for (int m = 0; m < 4; ++m) { const size_t ro = (size_t)(row0 + ai * HALF + m * 16) * 1024 + col0;
#pragma unroll
                for (int bj = 0; bj < 2; ++bj) { const u32x4 b = *(const u32x4*)(GB + ro + bj * HALF);
                    const f32x4 g0 = {bf_lo(b.x), bf_hi(b.x), bf_lo(b.y), bf_hi(b.y)}, g1 = {bf_lo(b.z), bf_hi(b.z), bf_lo(b.w), bf_hi(b.w)};
                    *(u32x4*)(OUT + ro + bj * HALF) = pack8(acc[ai][bj][m][0] * g0, acc[ai][bj][m][1] * g1); } }
    }
};
struct EpiRes {
    static constexpr bool PERM = false, DUAL = false;
    const float* base; float* out; bf16_t* xb; float* ssqp;
    __device__ __forceinline__ void mid(Acc& acc, const Unit& u, int wr, int wc, int fr, int fq) const {}
    __device__ __forceinline__ void operator()(const Acc& acc, const Unit& u, int wr, int wc, int fr, int fq) const {
        const int row0 = u.pm * BM + wr * 64 + fr, col0 = u.pn * BM + wc * 32 + 4 * fq;
#pragma unroll
        for (int ai = 0; ai < 2; ++ai)
#pragma unroll
            for (int m = 0; m < 4; ++m) { const int row = row0 + ai * HALF + m * 16; const size_t ro = (size_t)row * 1024 + col0; float ss = 0.f;
#pragma unroll
                for (int bj = 0; bj < 2; ++bj)
#pragma unroll
                    for (int n = 0; n < 2; ++n) { const size_t o = ro + bj * HALF + n * 16; const f32x4 v = *(const f32x4*)(base + o) + acc[ai][bj][m][n];
                        *(f32x4*)(out + o) = v; ss += (v[0] * v[0] + v[1] * v[1]) + (v[2] * v[2] + v[3] * v[3]);
                        if (xb) { u32x2 w; w.x = cvtpk(v[0], v[1]); w.y = cvtpk(v[2], v[3]); *(u32x2*)(xb + o) = w; } }
                ss += __shfl_xor(ss, 16); ss += __shfl_xor(ss, 32);
                if (fq == 0) ssqp[(size_t)row * 16 + u.pn * 4 + wc] = ss; }
    }
};
struct EpiFF1 {
    static constexpr bool PERM = true, DUAL = false;
    const float* ssqp; bf16_t* H;
    __device__ __forceinline__ void mid(Acc& acc, const Unit& u, int wr, int wc, int fr, int fq) const {}
    __device__ __forceinline__ void operator()(const Acc& acc, const Unit& u, int wr, int wc, int fr, int fq) const {
        const int row0 = u.pm * BM + wr * 64 + fr, col0 = u.pn * BM + wc * 32 + 8 * fq;
#pragma unroll
        for (int ai = 0; ai < 2; ++ai)
#pragma unroll
            for (int m = 0; m < 4; ++m) { const int row = row0 + ai * HALF + m * 16;
                const f32x4* sp = (const f32x4*)(ssqp + (size_t)row * 16); const f32x4 s = (sp[0] + sp[1]) + (sp[2] + sp[3]);
                const float rstd = __builtin_amdgcn_rsqf(((s[0] + s[1]) + (s[2] + s[3])) * (1.0f / D) + RMS_EPS);
#pragma unroll
                for (int bj = 0; bj < 2; ++bj) { f32x4 v0 = acc[ai][bj][m][0] * rstd, v1 = acc[ai][bj][m][1] * rstd;
#pragma unroll
                    for (int e = 0; e < 4; ++e) { const float a = fmaxf(v0[e], 0.f), b = fmaxf(v1[e], 0.f); v0[e] = a * a; v1[e] = b * b; }
                    *(u32x4*)(H + (size_t)row * FF + col0 + bj * HALF) = pack8(v0, v1); } }
    }
};
}


#define XB_TMO      128
#define XB_XCNT(j)  (256  + 64 * (j))
#define XB_XSUB(j)  (1280 + 64 * (j))
#define XB_XGEN(j)  (2304 + 64 * (j))
#define XB_TOP      3328
#define XB_TOPGEN   3392
#define XCD_BAR_WORDS 3456
#define XB_SPIN_CAP (1u << 18)
__device__ __forceinline__ unsigned xb_ld(unsigned* p)              { return __hip_atomic_load(p, __ATOMIC_RELAXED, __HIP_MEMORY_SCOPE_AGENT); }
__device__ __forceinline__ unsigned xb_add(unsigned* p, unsigned v) { return __hip_atomic_fetch_add(p, v, __ATOMIC_RELAXED, __HIP_MEMORY_SCOPE_AGENT); }
__device__ __forceinline__ unsigned xb_xcc_id() { return (unsigned)__builtin_amdgcn_s_getreg((3 << 11) | 20) & 0xFu; }
#define XB_SPIN(cond, bar) do { unsigned _sp = 0; while (cond) { __builtin_amdgcn_s_sleep(1); \
    if ((++_sp & 255u) == 0u) { if (xb_ld(&(bar)[XB_TMO])) break; if (_sp > XB_SPIN_CAP) { atomicAdd(&(bar)[XB_TMO], 1u); break; } } } } while (0)
struct XcdBarrier { unsigned* bar; unsigned x; volatile LAS unsigned* st; };
__device__ __forceinline__ XcdBarrier xcd_barrier_post(unsigned* bar, volatile LAS unsigned* st) {
    XcdBarrier b; b.bar = bar; b.x = xb_xcc_id(); b.st = st;
    if (threadIdx.x == 0) (void)xb_add(&bar[XB_XCNT(b.x)], 1u);
    return b;
}
__device__ __forceinline__ void xcd_barrier_complete(unsigned* bar, unsigned x, unsigned& nloc, unsigned& nx) {
    const unsigned G = gridDim.x * gridDim.y * gridDim.z;
    unsigned sum, cnt, mine, sp = 0u;
    for (;;) {
        sum = 0u; cnt = 0u; mine = 0u;
#pragma unroll
        for (unsigned j = 0; j < 16; ++j) { const unsigned c = xb_ld(&bar[XB_XCNT(j)]); sum += c; cnt += (c > 0u) ? 1u : 0u; mine = (j == x) ? c : mine; }
        if (sum == G) break;
        __builtin_amdgcn_s_sleep(1);
        if ((++sp & 255u) == 0u) { if (xb_ld(&bar[XB_TMO])) break; if (sp > XB_SPIN_CAP) { atomicAdd(&bar[XB_TMO], 1u); break; } }
    }
    nloc = mine > 0u ? mine : 1u; nx = cnt > 0u ? cnt : 1u;
}
__device__ __forceinline__ void xcd_barrier(const XcdBarrier& b) {
    asm volatile("s_waitcnt vmcnt(0)" ::: "memory");
    __syncthreads();
    if (threadIdx.x == 0) {
        unsigned* bar = b.bar;
        __builtin_amdgcn_s_waitcnt(0);
        unsigned nloc = b.st[0], nx = b.st[1];
        if (nloc == 0u) { xcd_barrier_complete(bar, b.x, nloc, nx); b.st[0] = nloc; b.st[1] = nx; }
        const unsigned old = xb_add(&bar[XB_XSUB(b.x)], 1u);
        const unsigned gen = old / nloc;
        if (old + 1u == (gen + 1u) * nloc) {
            __builtin_amdgcn_fence(__ATOMIC_RELEASE, "agent");
            asm volatile("s_waitcnt vmcnt(0)" ::: "memory");
            const unsigned og = xb_add(&bar[XB_TOP], 1u);
            const unsigned tg = og / nx;
            if (og + 1u == (tg + 1u) * nx) xb_add(&bar[XB_TOPGEN], 1u);
            else XB_SPIN(xb_ld(&bar[XB_TOPGEN]) == tg, bar);
            __builtin_amdgcn_fence(__ATOMIC_ACQUIRE, "agent");
            xb_add(&bar[XB_XGEN(b.x)], 1u);
            asm volatile("s_waitcnt vmcnt(0)" ::: "memory");
        } else {
            XB_SPIN(xb_ld(&bar[XB_XGEN(b.x)]) == gen, bar);
            __builtin_amdgcn_fence(__ATOMIC_ACQUIRE, "agent");
            asm volatile("s_waitcnt vmcnt(0)" ::: "memory");
        }
    }
    __syncthreads();
}

struct Args {
    const float *x, *rel, *g_attn, *w_in, *b_forget, *pe_k, *cw1_k, *cw2_k, *pe_v, *cw1_v, *cw2_v, *w_br_fox, *w_br_nsa, *w_out, *g_mlp, *w_ff1, *w_ff2, *g_final;
    float* out; unsigned char* ws; int ph_lo, ph_hi;
};
struct Frame { LAS unsigned char* lds; int tid, lane, wave, G, bid; };

__device__ __forceinline__ float wave_sum(float v) {
#pragma unroll
    for (int o = 1; o < 64; o <<= 1) v += __shfl_xor(v, o);
    return v;
}

__device__ __forceinline__ int win_srccol(int n) {
    if (n < 1536) return n; if (n < 2816) return n + 8; if (n < 4864) return n + 32;
    if (n < 4872) return n - 4864 + 1536; if (n < 4896) return n - 4872 + 2824; return -1;
}
template <bool MAP>
__device__ __forceinline__ void transpose_item(const float* W, int K, int Nsrc, int nblk, bf16_t* WT, LAS float* scr, int item, int lane, const float* kscale) {
    const int kb = item / nblk, nb = item % nblk, k0 = 64 * kb, n0 = 32 * nb;
    const int nd = n0 + (lane & 31), ns = MAP ? win_srccol(nd) : nd;
#pragma unroll 8
    for (int i = 0; i < 32; ++i) { const int kk = 2 * i + (lane >> 5); float v = (ns >= 0) ? W[(size_t)(k0 + kk) * Nsrc + ns] : 0.f; if (kscale) v *= kscale[k0 + kk]; scr[kk * 33 + (lane & 31)] = v; }
    LDS_WAIT(); asm volatile("" ::: "memory");
    const int c = lane & 7;
#pragma unroll
    for (int j = 0; j < 4; ++j) { const int n = (lane >> 3) + 8 * j; const LAS float* s = scr + (8 * c) * 33 + n;
        u32x4 o; o.x = cvtpk(s[0 * 33], s[1 * 33]); o.y = cvtpk(s[2 * 33], s[3 * 33]); o.z = cvtpk(s[4 * 33], s[5 * 33]); o.w = cvtpk(s[6 * 33], s[7 * 33]);
        *(u32x4*)(WT + (size_t)(n0 + n) * K + k0 + 8 * c) = o; }
    LDS_WAIT(); asm volatile("" ::: "memory");
}
__device__ __forceinline__ int rel_bucket(int n) {
    if (n < 16) return n;
    int lb = 16 + (int)(logf((float)n / 16.0f) / 2.0794415416798357f * 16.0f);
    return lb < 31 ? lb : 31;
}
__device__ __forceinline__ void p0_prologue(const Frame& F, const Args& a) {
    unsigned char* ws = a.ws;
    LAS float* scr = (LAS float*)(F.lds + F.wave * 16384);
    const int gw = F.bid * NWAVES + F.wave, NGW = F.G * NWAVES;
    constexpr int I_IN = 16 * 160, I_BR = 8 * 32, I_OUT = 16 * 32, I_1 = 16 * 128, I_2 = 64 * 32, I_C1 = 32 * 8, I_C2 = 4 * 2;
    constexpr int NITEMS = I_IN + 2 * I_BR + I_OUT + I_1 + I_2 + 2 * I_C1 + 2 * I_C2;
    for (int it = gw; it < NITEMS; it += NGW) {
        int r = it;
        if (r < I_IN) { transpose_item<true>(a.w_in, 1024, 4896, 160, (bf16_t*)(ws + WS_WIN), scr, r, F.lane, nullptr); continue; } r -= I_IN;
        if (r < I_BR) { transpose_item<false>(a.w_br_fox, 512, 1024, 32, (bf16_t*)(ws + WS_WF), scr, r, F.lane, nullptr); continue; } r -= I_BR;
        if (r < I_BR) { transpose_item<false>(a.w_br_nsa, 512, 1024, 32, (bf16_t*)(ws + WS_WN), scr, r, F.lane, nullptr); continue; } r -= I_BR;
        if (r < I_OUT) { transpose_item<false>(a.w_out, 1024, 1024, 32, (bf16_t*)(ws + WS_WOUT), scr, r, F.lane, nullptr); continue; } r -= I_OUT;
        if (r < I_1) { transpose_item<false>(a.w_ff1, 1024, 4096, 128, (bf16_t*)(ws + WS_W1), scr, r, F.lane, a.g_mlp); continue; } r -= I_1;
        if (r < I_2) { transpose_item<false>(a.w_ff2, 4096, 1024, 32, (bf16_t*)(ws + WS_W2), scr, r, F.lane, nullptr); continue; } r -= I_2;
        if (r < I_C1) { transpose_item<false>(a.cw1_k, 2048, 256, 8, (bf16_t*)(ws + WS_CW1), scr, r, F.lane, nullptr); continue; } r -= I_C1;
        if (r < I_C1) { transpose_item<false>(a.cw1_v, 2048, 256, 8, (bf16_t*)(ws + WS_CW1) + 256 * 2048, scr, r, F.lane, nullptr); continue; } r -= I_C1;
        if (r < I_C2) { transpose_item<false>(a.cw2_k, 256, 64, 2, (bf16_t*)(ws + WS_CW2T), scr, r, F.lane, nullptr); continue; } r -= I_C2;
        transpose_item<false>(a.cw2_v, 256, 64, 2, (bf16_t*)(ws + WS_CW2T) + 64 * 256, scr, r, F.lane, nullptr);
    }
    {
        bf16_t* XN = (bf16_t*)(ws + WS_XN);
        const f32x4* gp = (const f32x4*)a.g_attn + F.lane; f32x4 gv[4];
#pragma unroll
        for (int j = 0; j < 4; ++j) gv[j] = gp[64 * j];
        for (int m = gw; m < M; m += NGW) {
            const f32x4* xr = (const f32x4*)(a.x + (size_t)m * D) + F.lane; f32x4 v[4]; float s = 0.f;
#pragma unroll
            for (int j = 0; j < 4; ++j) { v[j] = xr[64 * j]; s += (v[j][0] * v[j][0] + v[j][1] * v[j][1]) + (v[j][2] * v[j][2] + v[j][3] * v[j][3]); }
            const float rstd = 1.0f / sqrtf(wave_sum(s) * (1.0f / D) + RMS_EPS);
            u32x2* o8 = (u32x2*)(XN + (size_t)m * D) + F.lane;
#pragma unroll
            for (int j = 0; j < 4; ++j) { const f32x4 y = v[j] * rstd * gv[j]; u32x2 w; w.x = cvtpk(y[0], y[1]); w.y = cvtpk(y[2], y[3]); o8[64 * j] = w; }
        }
    }
    for (int it = gw; it < 64; it += NGW) {
        const int kv = it >> 5, jb = (it >> 3) & 3, ic = it & 7; const float* pe = kv ? a.pe_v : a.pe_k; const float* w1 = kv ? a.cw1_v : a.cw1_k;
        const int j = jb * 64 + F.lane; float s = 0.f;
#pragma unroll 8
        for (int i = ic * 256; i < ic * 256 + 256; ++i) s += pe[i] * w1[(size_t)i * 256 + j];
        atomicAdd((float*)(ws + WS_CB1) + kv * 256 + j, s);
    }
    for (int i = F.bid * 512 + F.tid; i < 8 * 384; i += F.G * 512) {
        const int h = i / 384, e = i % 384; float v;
        if (e < 256) { const int n = e - 64; v = (n < 0) ? NEGBIG : a.rel[rel_bucket(n < 128 ? n : 128) * 8 + h] * LOG2E; }
        else { const int n = 448 + (e - 256); v = (n < 512) ? a.rel[31 * 8 + h] * LOG2E : NEGBIG; }
        ((float*)(ws + WS_LUT))[i] = v;
    }
}

__device__ __forceinline__ float log_sigmoid(float x) { return fminf(x, 0.f) - log1pf(expf(-fabsf(x))); }
__device__ __forceinline__ void scan_seq(const Args& a, int seq, int lane) {
    const int b = seq >> 3, h = seq & 7; const float bf = a.b_forget[h];
    const float* sm = (const float*)(a.ws + WS_SMALL) + ((size_t)b * T + lane * 64) * 32 + h;
    float tot = 0.f;
#pragma unroll 8
    for (int i = 0; i < 64; ++i) tot += log_sigmoid(sm[(size_t)i * 32] + bf);
    float inc = tot;
#pragma unroll
    for (int o = 1; o < 64; o <<= 1) { const float t = __shfl_up(inc, o); if (lane >= o) inc += t; }
    float run = inc - tot;
    u32x4* fb = (u32x4*)((bf16_t*)(a.ws + WS_FB) + ((size_t)seq * T + lane * 64) * 16);
#pragma unroll 4
    for (int i = 0; i < 64; ++i) {
        run += log_sigmoid(sm[(size_t)i * 32] + bf);
        const float v = -run * LOG2E;
        const unsigned w0 = cvtpk(v, 0.f) & 0xffffu; const float r1 = v - __uint_as_float(w0 << 16);
        const unsigned w1 = cvtpk(r1, 0.f) & 0xffffu; const float r2 = r1 - __uint_as_float(w1 << 16);
        const unsigned w2 = cvtpk(r2, 0.f) & 0xffffu;
        fb[2 * i] = (u32x4){w0 | (w1 << 16), w2, 0u, 0u}; fb[2 * i + 1] = (u32x4){0u, 0u, 0u, 0u};
    }
}
__device__ __forceinline__ void compress_unit(const Frame& F, const Args& a, int unit) {
    const int kv = unit >> 5, bg = (unit >> 2) & 7, ct = unit & 3, c0 = ct * 64;
    const int lane = F.lane, r32 = lane & 31, hi = lane >> 5, w = F.wave;
    const bf16_t* data = (const bf16_t*)(a.ws + WS_KV6) + (size_t)kv * KV6_ELEMS + (size_t)bg * T * 64;
    const bf16_t* w1t = (const bf16_t*)(a.ws + WS_CW1) + (size_t)kv * 256 * 2048;
    const bf16_t* w2t = (const bf16_t*)(a.ws + WS_CW2T) + (size_t)kv * 64 * 256;
    const float* cb1 = (const float*)(a.ws + WS_CB1) + kv * 256;
    LAS float* red = (LAS float*)F.lds;
    for (int i = F.tid; i < 4096; i += 512) red[i] = 0.f;
    const bf16_t* ap = w1t + (size_t)(32 * w + r32) * 2048 + 8 * hi;
    const bf16_t* bp0 = data + (size_t)(c0 + r32) * 1024 + 8 * hi;
    const bf16_t* bp1 = bp0 + 32 * 1024;
    f32x16 h0 = {}, h1 = {};
#pragma unroll 4
    for (int ks = 0; ks < 128; ++ks) {
        const bf16x8 af = *(const bf16x8*)(ap + ks * 16), b0 = *(const bf16x8*)(bp0 + ks * 16), b1 = *(const bf16x8*)(bp1 + ks * 16);
        h0 = __builtin_amdgcn_mfma_f32_32x32x16_bf16(af, b0, h0, 0, 0, 0);
        h1 = __builtin_amdgcn_mfma_f32_32x32x16_bf16(af, b1, h1, 0, 0, 0);
    }
#pragma unroll
    for (int r = 0; r < 16; ++r) { const float bj = cb1[32 * w + crow(r, hi)]; float x0 = h0[r] + bj, x1 = h1[r] + bj; h0[r] = x0 * fsigmoid(x0); h1[r] = x1 * fsigmoid(x1); }
    f32x16 po[2][2] = {};
#pragma unroll
    for (int s = 0; s < 2; ++s) {
        bf16x8 xb0, xb1;
        { u32x4 t0, t1;
          t0.x = cvtpk(h0[8 * s + 0], h0[8 * s + 1]); t0.y = cvtpk(h0[8 * s + 2], h0[8 * s + 3]); t0.z = cvtpk(h0[8 * s + 4], h0[8 * s + 5]); t0.w = cvtpk(h0[8 * s + 6], h0[8 * s + 7]);
          t1.x = cvtpk(h1[8 * s + 0], h1[8 * s + 1]); t1.y = cvtpk(h1[8 * s + 2], h1[8 * s + 3]); t1.z = cvtpk(h1[8 * s + 4], h1[8 * s + 5]); t1.w = cvtpk(h1[8 * s + 6], h1[8 * s + 7]);
          xb0 = __builtin_bit_cast(bf16x8, t0); xb1 = __builtin_bit_cast(bf16x8, t1); }
#pragma unroll
        for (int dt = 0; dt < 2; ++dt) {
            const bf16_t* wp = w2t + (size_t)(dt * 32 + r32) * 256 + 32 * w + 16 * s + 4 * hi;
            const u32x2 lo = *(const u32x2*)wp, hi2 = *(const u32x2*)(wp + 8);
            const bf16x8 wa = __builtin_bit_cast(bf16x8, (u32x4){lo.x, lo.y, hi2.x, hi2.y});
            po[dt][0] = __builtin_amdgcn_mfma_f32_32x32x16_bf16(wa, xb0, po[dt][0], 0, 0, 0);
            po[dt][1] = __builtin_amdgcn_mfma_f32_32x32x16_bf16(wa, xb1, po[dt][1], 0, 0, 0);
        }
    }
    __syncthreads();
#pragma unroll
    for (int dt = 0; dt < 2; ++dt)
#pragma unroll
        for (int cti = 0; cti < 2; ++cti)
#pragma unroll
            for (int r = 0; r < 16; ++r) __hip_atomic_fetch_add(red + (cti * 32 + r32) * 64 + dt * 32 + crow(r, hi), po[dt][cti][r], __ATOMIC_RELAXED, __HIP_MEMORY_SCOPE_WORKGROUP);
    __syncthreads();
    { const int c = F.tid >> 3, dc = (F.tid & 7) * 8; const LAS float* s = red + c * 64 + dc;
      u32x4 o; o.x = cvtpk(s[0], s[1]); o.y = cvtpk(s[2], s[3]); o.z = cvtpk(s[4], s[5]); o.w = cvtpk(s[6], s[7]);
      if (c0 + c == 255) o = (u32x4){0u, 0u, 0u, 0u};
      *(u32x4*)((bf16_t*)(a.ws + WS_KC) + ((size_t)(kv * 8 + bg) * 256 + c0 + c) * 64 + dc) = o; }
    __syncthreads();
}

__device__ __forceinline__ void glds16(const void* gsrc, unsigned lds_dst) { unsigned keep;
    asm volatile("s_mov_b32 %0, m0\n\ts_mov_b32 m0, %2\n\ts_nop 0\n\tglobal_load_lds_dwordx4 %1, off\n\ts_mov_b32 m0, %0" : "=&s"(keep) : "v"(gsrc), "s"(lds_dst) : "memory"); }
__device__ __forceinline__ float rowmax32(const f32x16& p0, const f32x16& p1) {
    float a = fmaxf(p0[0], p1[0]);
#pragma unroll
    for (int r = 1; r < 16; ++r) a = fmaxf(a, fmaxf(p0[r], p1[r]));
    auto rr = __builtin_amdgcn_permlane32_swap(__float_as_uint(a), __float_as_uint(a), false, false);
    return fmaxf(__uint_as_float(rr[0]), __uint_as_float(rr[1]));
}
__device__ __forceinline__ float swap_other(float v, int hi) {
    auto rr = __builtin_amdgcn_permlane32_swap(__float_as_uint(v), __float_as_uint(v), false, false);
    return __uint_as_float(hi ? rr[0] : rr[1]);
}
__device__ __forceinline__ unsigned swap_other_u(unsigned v, int hi) {
    auto rr = __builtin_amdgcn_permlane32_swap(v, v, false, false);
    return hi ? rr[0] : rr[1];
}
template <int NK>
__device__ __forceinline__ void qkt(f32x16& p0, f32x16& p1, const LAS unsigned char* Kslot, const bf16x8* qr, float cinit, int r32, int hi) {
    unsigned kbu = (unsigned)(uintptr_t)(Kslot + hi * 1024 + r32 * 16); OPAQUE(kbu); const LAS unsigned char* kb = (const LAS unsigned char*)kbu;
    f32x16 c;
#pragma unroll
    for (int r = 0; r < 16; ++r) c[r] = cinit;
    p0 = c; p1 = c;
#pragma unroll
    for (int d0 = 0; d0 < NK; ++d0) {
        const bf16x8 b0 = *(const LAS bf16x8*)(kb + d0 * 2048);
        const bf16x8 b1 = *(const LAS bf16x8*)(kb + d0 * 2048 + 512);
        p0 = __builtin_amdgcn_mfma_f32_32x32x16_bf16(b0, qr[d0], p0, 0, 0, 0);
        p1 = __builtin_amdgcn_mfma_f32_32x32x16_bf16(b1, qr[d0], p1, 0, 0, 0);
    }
}
__device__ __forceinline__ void pv(f32x16* o, unsigned vb, bf16x8 pa0, bf16x8 pa1, bf16x8 pa2, bf16x8 pa3) {
#pragma unroll
    for (int d0 = 0; d0 < 2; ++d0) { s16x4 lo[4], hi[4];
#pragma unroll
        for (int ks = 0; ks < 4; ++ks) {
            asm volatile("ds_read_b64_tr_b16 %0,%1 offset:%c2" : "=&v"(lo[ks]) : "v"(vb), "i"(d0 * 4096 + ks * 1024) : "memory");
            asm volatile("ds_read_b64_tr_b16 %0,%1 offset:%c2" : "=&v"(hi[ks]) : "v"(vb), "i"(d0 * 4096 + ks * 1024 + 512) : "memory"); }
        asm volatile("s_waitcnt lgkmcnt(0)" ::: "memory"); SBAR();
#define PK(k) (bf16x8){lo[k][0], lo[k][1], lo[k][2], lo[k][3], hi[k][0], hi[k][1], hi[k][2], hi[k][3]}
        o[d0] = __builtin_amdgcn_mfma_f32_32x32x16_bf16(pa0, PK(0), o[d0], 0, 0, 0);
        o[d0] = __builtin_amdgcn_mfma_f32_32x32x16_bf16(pa1, PK(1), o[d0], 0, 0, 0);
        o[d0] = __builtin_amdgcn_mfma_f32_32x32x16_bf16(pa2, PK(2), o[d0], 0, 0, 0);
        o[d0] = __builtin_amdgcn_mfma_f32_32x32x16_bf16(pa3, PK(3), o[d0], 0, 0, 0);
#undef PK
    }
}
__device__ __forceinline__ float softmax_pv(f32x16& p0, f32x16& p1, float& mhat, float& l, f32x16* o, volatile LAS float* wsf, unsigned vb, int r32, int hi) {
    const float rm = rowmax32(p0, p1);
    float f = 1.0f;
    if (__any(rm > 0.f)) {
        const float dl = fmaxf(rm, 0.f); mhat += dl;
#pragma unroll
        for (int r = 0; r < 16; ++r) { p0[r] -= dl; p1[r] -= dl; }
        f = __builtin_amdgcn_exp2f(-dl); l *= f;
        if (hi == 0) wsf[r32] = f;
        LDS_WAIT();
        { unsigned wb = (unsigned)(uintptr_t)(wsf + 4 * hi); OPAQUE(wb); volatile LAS float* wq = (volatile LAS float*)wb;
#pragma unroll
        for (int r = 0; r < 16; ++r) { const float ff = wq[(r & 3) + 8 * (r >> 2)]; o[0][r] *= ff; o[1][r] *= ff; } }
    }
    float s = 0.f;
#pragma unroll
    for (int r = 0; r < 16; ++r) { p0[r] = __builtin_amdgcn_exp2f(p0[r]); p1[r] = __builtin_amdgcn_exp2f(p1[r]); s += p0[r] + p1[r]; }
    l += s;
    u32x4 w0, w1, w2, w3;
    w0 = (u32x4){cvtpk(p0[0], p0[1]), cvtpk(p0[2], p0[3]), cvtpk(p0[4], p0[5]), cvtpk(p0[6], p0[7])};
    w1 = (u32x4){cvtpk(p0[8], p0[9]), cvtpk(p0[10], p0[11]), cvtpk(p0[12], p0[13]), cvtpk(p0[14], p0[15])};
    w2 = (u32x4){cvtpk(p1[0], p1[1]), cvtpk(p1[2], p1[3]), cvtpk(p1[4], p1[5]), cvtpk(p1[6], p1[7])};
    w3 = (u32x4){cvtpk(p1[8], p1[9]), cvtpk(p1[10], p1[11]), cvtpk(p1[12], p1[13]), cvtpk(p1[14], p1[15])};
    pv(o, vb, __builtin_bit_cast(bf16x8, w0), __builtin_bit_cast(bf16x8, w1), __builtin_bit_cast(bf16x8, w2), __builtin_bit_cast(bf16x8, w3));
    return f;
}
__device__ __forceinline__ void lut_bias(f32x16& p0, f32x16& p1, const LAS float* lut, int d0, int hi) {
    const LAS float* lp = lut + (d0 - 4 * hi - 63);
#pragma unroll
    for (int r = 0; r < 16; ++r) { const int ko = (r & 3) + 8 * (r >> 2);
        p0[r] += lp[63 - ko]; p1[r] += lp[63 - ko - 32]; }
}
__device__ __forceinline__ void lut_bias_cmp(f32x16& p0, f32x16& p1, const LAS float* lut, int d0, int hi) {
#pragma unroll
    for (int r = 0; r < 16; ++r) { const int ko = (r & 3) + 8 * (r >> 2) + 4 * hi;
        int n0 = d0 - 16 * ko, n1 = n0 - 512;
        n0 = n0 < -1 ? -1 : (n0 > 128 ? 128 : n0); n1 = n1 < -1 ? -1 : (n1 > 128 ? 128 : n1);
        p0[r] += lut[n0]; p1[r] += lut[n1]; }
}
__device__ __forceinline__ void cmask(f32x16& p0, f32x16& p1, int jb, int qrel, int hi) {
    const int kb = 64 * jb + 4 * hi;
#pragma unroll
    for (int r = 0; r < 16; ++r) { const int kv = kb + (r & 3) + 8 * (r >> 2); if (kv > qrel) p0[r] = NEGBIG; if (kv + 32 > qrel) p1[r] = NEGBIG; }
}
#define WAIT_BAR0() asm volatile("s_waitcnt vmcnt(0) lgkmcnt(0)\n\ts_barrier" ::: "memory")

__device__ __forceinline__ void fox_unit(const Frame& F, const Args& a, int b, int h, int qb) {
    const int lane = F.lane, r32 = lane & 31, hi = lane >> 5, wid = F.wave;
    const unsigned lds0 = (unsigned)(uintptr_t)F.lds;
    const bf16_t* FQ = (const bf16_t*)(a.ws + WS_FQ); const bf16_t* FK = (const bf16_t*)(a.ws + WS_FK); const bf16_t* FV = (const bf16_t*)(a.ws + WS_FV);
    const bf16_t* FB = (const bf16_t*)(a.ws + WS_FB) + (size_t)(b * 8 + h) * T * 16;
    bf16_t* O = (bf16_t*)(a.ws + WS_OFOX);
    const long rowbase = (long)b * T; const int q0 = qb * 256;
    const bf16_t* Kh = FK + rowbase * 512 + h * 64; const bf16_t* Vh = FV + rowbase * 512 + h * 64;
    const bf16_t* ksrc = Kh + (long)lane * 512 + wid * 8;
    const bf16_t* vsrc = Vh + (long)(16 * (wid & 3) + (lane >> 2)) * 512 + (wid >> 2) * 32 + (lane & 3) * 8;
    const bf16_t* fsrc = FB + (long)lane * 16 + (wid & 1) * 8;
    const unsigned kdst = lds0 + L_K + wid * 1024, vdst = lds0 + L_V + wid * 1024, fdst = lds0 + L_K + 8192 + (wid & 1) * 1024;
#define FOX_DMA(t, s) do { glds16(ksrc + (long)(t) * 64 * 512, (unsigned)__builtin_amdgcn_readfirstlane(kdst + (s) * KSLOT)); glds16(vsrc + (long)(t) * 64 * 512, (unsigned)__builtin_amdgcn_readfirstlane(vdst + (s) * VSLOT)); \
        if (wid < 2) glds16(fsrc + (long)(t) * 64 * 16, (unsigned)__builtin_amdgcn_readfirstlane(fdst + (s) * KSLOT)); } while (0)
    const unsigned vb0 = lds0 + L_V + ((lane >> 4) & 1) * 32 + (lane & 3) * 8 + (4 * hi + ((lane & 15) >> 2)) * 64;
    volatile LAS float* wsf = (volatile LAS float*)(F.lds + L_WSF) + wid * 64;
    const int NT = (q0 + 256) / 64;
    __syncthreads();
    FOX_DMA(0, 0);
    bf16x8 qr[5];
    { const bf16_t* Qw = FQ + (rowbase + q0 + wid * 32 + r32) * 512 + h * 64;
#pragma unroll
      for (int d0 = 0; d0 < 4; ++d0) qr[d0] = *(const bf16x8*)(Qw + d0 * 16 + hi * 8);
      const short one = (short)0x3f80; qr[4] = hi ? (bf16x8){0, 0, 0, 0, 0, 0, 0, 0} : (bf16x8){one, one, one, 0, 0, 0, 0, 0}; }
    float mhat = -100.f, l = 0.f; f32x16 o[2]; o[0] = f32x16{}; o[1] = f32x16{};
    const int qrel = wid * 32 + r32;
#pragma unroll 1
    for (int t = 0; t < NT; ++t) {
        WAIT_BAR0();
        if (t + 1 < NT) FOX_DMA(t + 1, (t + 1) & 1);
        f32x16 p0, p1;
        qkt<5>(p0, p1, F.lds + L_K + (t & 1) * KSLOT, qr, -mhat, r32, hi);
        const int jb = t - (NT - 4); if (jb >= 0) cmask(p0, p1, jb, qrel, hi);
        softmax_pv(p0, p1, mhat, l, o, wsf, vb0 + (t & 1) * VSLOT, r32, hi);
    }
    l += swap_other(l, hi);
    if (hi == 0) wsf[32 + r32] = l; LDS_WAIT();
    LAS bf16_t* st = (LAS bf16_t*)(F.lds + L_OST) + wid * 2048;
#pragma unroll
    for (int r = 0; r < 16; ++r) { const int orow = crow(r, hi); const float rl = __builtin_amdgcn_rcpf(wsf[32 + orow]);
#pragma unroll
        for (int d0 = 0; d0 < 2; ++d0) { const unsigned w = cvtpk(o[d0][r] * rl, 0.f); st[orow * 64 + d0 * 32 + r32] = (bf16_t)(w & 0xffffu); } }
    LDS_WAIT();
    bf16_t* Ow = O + (rowbase + q0 + wid * 32) * 512 + h * 64;
#pragma unroll
    for (int i = 0; i < 4; ++i) { const int row = i * 8 + (lane >> 3), ch = lane & 7; const u32x4 v = *(const LAS u32x4*)(st + row * 64 + ch * 8); *(u32x4*)(Ow + (long)row * 512 + ch * 8) = v; }
#undef FOX_DMA
}

__device__ __forceinline__ void nsa_unit(const Frame& F, const Args& a, int bg, int qb) {
    const int wid = F.wave;
    const int b = bg >> 1, g = bg & 1, q0 = qb * 64;
#define NSA_CTX() int lane = F.lane; OPAQUE(lane); const int r32 = lane & 31, hi = lane >> 5; \
    const unsigned lds0 = (unsigned)(uintptr_t)F.lds; \
    const int tok = r32 & 7, hh = r32 >> 3, h = g * 4 + hh, qpos = q0 + 8 * wid + tok; (void)h; (void)qpos; \
    const int koff = lane * 64 + wid * 8, voff = (16 * (wid & 3) + (lane >> 2)) * 64 + (wid >> 2) * 32 + (lane & 3) * 8; (void)koff; (void)voff; \
    const unsigned kdst = lds0 + L_K + wid * 1024, vdst = lds0 + L_V + wid * 1024; (void)kdst; (void)vdst; \
    const unsigned vb0 = lds0 + L_V + ((lane >> 4) & 1) * 32 + (lane & 3) * 8 + (4 * hi + ((lane & 15) >> 2)) * 64; (void)vb0; \
    volatile LAS float* wsf = (volatile LAS float*)(F.lds + L_WSF) + wid * 64; (void)wsf; \
    LAS float* ost = (LAS float*)(F.lds + L_OST) + wid * 2048; (void)ost; \
    const LAS float* lut = (const LAS float*)(F.lds + L_LUT) + hh * 384 + 64; (void)lut
#define NSA_DMA(Kp, Vp, t, s) do { glds16((Kp) + (size_t)(t) * 4096 + koff, (unsigned)__builtin_amdgcn_readfirstlane(kdst + (s) * KSLOT)); glds16((Vp) + (size_t)(t) * 4096 + voff, (unsigned)__builtin_amdgcn_readfirstlane(vdst + (s) * VSLOT)); } while (0)
#define BR_BEGIN() do { mhat = -100.f; l = 0.f; o[0] = f32x16{}; o[1] = f32x16{}; } while (0)
#define BR_END(gate, FIRST) do { l += swap_other(l, hi); const float fac = (l > 0.f) ? (gate) * __builtin_amdgcn_rcpf(l) : 0.f; \
        if (hi == 0) wsf[r32] = fac; LDS_WAIT(); \
        unsigned wb_ = (unsigned)(uintptr_t)(wsf + 4 * hi), ob_ = (unsigned)(uintptr_t)(ost + 4 * hi * 64 + r32); OPAQUE(wb_); OPAQUE(ob_); \
        volatile LAS float* wq_ = (volatile LAS float*)wb_; LAS float* oq_ = (LAS float*)ob_; \
        _Pragma("unroll") for (int r = 0; r < 16; ++r) { const float ff = wq_[(r & 3) + 8 * (r >> 2)]; LAS float* dst = oq_ + ((r & 3) + 8 * (r >> 2)) * 64; \
            if (FIRST) { dst[0] = o[0][r] * ff; dst[32] = o[1][r] * ff; } else { dst[0] += o[0][r] * ff; dst[32] += o[1][r] * ff; } } LDS_WAIT(); } while (0)
    const bf16_t* KV6 = (const bf16_t*)(a.ws + WS_KV6);
    __syncthreads();
    { const float* lg = (const float*)(a.ws + WS_LUT) + (size_t)g * 4 * 384; LAS float* lutl = (LAS float*)(F.lds + L_LUT); for (int i = F.tid; i < 4 * 384; i += 512) lutl[i] = lg[i]; }
    bf16x8 qr[4];
    float gate0, gate1, gate2, b31;
    { NSA_CTX();
      const size_t row = (size_t)b * T + qpos;
      const bf16_t* Qw = (const bf16_t*)(a.ws + WS_NQ) + row * 512 + h * 64;
#pragma unroll
      for (int d0 = 0; d0 < 4; ++d0) qr[d0] = *(const bf16x8*)(Qw + d0 * 16 + hi * 8);
      const float* gl = (const float*)(a.ws + WS_SMALL) + row * 32 + 8 + h * 3;
      gate0 = fsigmoid(gl[0]); gate1 = fsigmoid(gl[1]); gate2 = fsigmoid(gl[2]);
      b31 = ((const float*)(a.ws + WS_LUT))[(size_t)h * 384 + 64 + 128]; }
    float mhat, l; f32x16 o[2];

    unsigned long long selmask;
    {
        NSA_CTX();
        const bf16_t* KCp = (const bf16_t*)(a.ws + WS_KC) + (size_t)bg * 256 * 64; const bf16_t* VCp = KCp + (size_t)8 * 256 * 64;
        const int cmax = (q0 + 63 - 31) >> 4, ncmp = (cmax >> 6) + 1;
        float imp[32];
#pragma unroll
        for (int i = 0; i < 32; ++i) imp[i] = 0.f;
        float carry = 0.f;
        BR_BEGIN();
        __syncthreads();
        NSA_DMA(KCp, VCp, 0, 0);
#pragma unroll
        for (int i = 0; i < 4; ++i) {
            if (i < ncmp) {
                WAIT_BAR0();
                if (i + 1 < ncmp) NSA_DMA(KCp, VCp, i + 1, (i + 1) & 1);
                f32x16 p0, p1;
                qkt<4>(p0, p1, F.lds + L_K + (i & 1) * KSLOT, qr, -mhat, r32, hi);
                lut_bias_cmp(p0, p1, lut, qpos - 31 - 1024 * i, hi);
                const float f = softmax_pv(p0, p1, mhat, l, o, wsf, vb0 + (i & 1) * VSLOT, r32, hi);
#pragma unroll
                for (int k = 0; k < 8 * i; ++k) imp[k] *= f;
                carry *= f;
                float e3[8];
#pragma unroll
                for (int k = 0; k < 8; ++k) { const f32x16& pp = (k < 4) ? p0 : p1; const int rb = 4 * (k & 3);
                    imp[8 * i + k] = (pp[rb] + pp[rb + 1]) + (pp[rb + 2] + pp[rb + 3]); e3[k] = pp[rb + 3]; }
                float pe3[8];
#pragma unroll
                for (int k = 0; k < 8; ++k) pe3[k] = swap_other(e3[k], hi);
#pragma unroll
                for (int k = 0; k < 8; ++k) imp[8 * i + k] += hi ? pe3[k] : (k == 0 ? carry : pe3[k - 1]);
                carry = pe3[7];
            }
        }
        BR_END(gate0, true);
        const float rl = (l > 0.f) ? __builtin_amdgcn_rcpf(l) : 0.f;
        const int cur = qpos >> 6;
        unsigned key[32];
#pragma unroll
        for (int i = 0; i < 32; ++i) { float v = imp[i] * rl; v += __shfl_xor(v, 8); v += __shfl_xor(v, 16);
            const int s = 16 * (i >> 3) + 2 * (i & 7) + hi;
            unsigned kbits = (__float_as_uint(v) & ~63u) | (unsigned)(63 - s);
            if (s == 0 || s == cur || s == cur - 1) kbits = 0x7f000000u | (unsigned)(63 - s);
            if (s > cur) kbits = 0u;
            key[i] = kbits; }
        unsigned long long msk = 0ull;
#pragma unroll 1
        for (int pass = 0; pass < 16; ++pass) {
            unsigned mx = key[0];
#pragma unroll
            for (int i = 1; i < 32; ++i) mx = mx > key[i] ? mx : key[i];
            const unsigned om = swap_other_u(mx, hi); mx = mx > om ? mx : om;
            if (mx != 0u) msk |= 1ull << (63 - (int)(mx & 63u));
#pragma unroll
            for (int i = 0; i < 32; ++i) key[i] = (key[i] == mx) ? 0u : key[i];
        }
        selmask = msk;
    }
#ifndef NO_SEL
    {
        NSA_CTX();
        const bf16_t* KSL = KV6 + 2 * KV6_ELEMS + (size_t)bg * T * 64; const bf16_t* VSL = KV6 + 3 * KV6_ELEMS + (size_t)bg * T * 64;
        BR_BEGIN();
        const int nt = qb + 1;
        __syncthreads();
        NSA_DMA(KSL, VSL, 0, 0);
#pragma unroll 1
        for (int t = 0; t < nt; ++t) {
            WAIT_BAR0();
            if (t + 1 < nt) NSA_DMA(KSL, VSL, t + 1, (t + 1) & 1);
            const bool sel = (selmask >> t) & 1ull;
            const bool band = (t >= qb - 2);
            f32x16 p0, p1;
            qkt<4>(p0, p1, F.lds + L_K + (t & 1) * KSLOT, qr, sel ? (band ? -mhat : b31 - mhat) : NEGBIG, r32, hi);
            if (band) lut_bias(p0, p1, lut, qpos - 64 * t, hi);
            softmax_pv(p0, p1, mhat, l, o, wsf, vb0 + (t & 1) * VSLOT, r32, hi);
        }
        BR_END(gate1, false);
    }
#endif
#ifndef NO_WIN
    {
        NSA_CTX();
        const bf16_t* KWN = KV6 + 4 * KV6_ELEMS + (size_t)bg * T * 64; const bf16_t* VWN = KV6 + 5 * KV6_ELEMS + (size_t)bg * T * 64;
        const LAS float* lutw = lut - 64 + 256 - 448;
        BR_BEGIN();
        const int t0 = qb >= 8 ? qb - 8 : 0, nt = qb - t0 + 1;
        __syncthreads();
        NSA_DMA(KWN, VWN, t0, 0);
#pragma unroll 1
        for (int i = 0; i < nt; ++i) {
            const int t = t0 + i;
            WAIT_BAR0();
            if (i + 1 < nt) NSA_DMA(KWN, VWN, t + 1, (i + 1) & 1);
            const bool band = (t >= qb - 2), far = (t == qb - 8);
            f32x16 p0, p1;
            qkt<4>(p0, p1, F.lds + L_K + (i & 1) * KSLOT, qr, (band || far) ? -mhat : b31 - mhat, r32, hi);
            if (band) lut_bias(p0, p1, lut, qpos - 64 * t, hi);
            else if (far) lut_bias(p0, p1, lutw, qpos - 64 * t, hi);
            softmax_pv(p0, p1, mhat, l, o, wsf, vb0 + (i & 1) * VSLOT, r32, hi);
        }
        BR_END(gate2, false);
    }
#endif
    {
        NSA_CTX();
        bf16_t* O = (bf16_t*)(a.ws + WS_ONSA);
#pragma unroll
        for (int i = 0; i < 4; ++i) { const int rr = i * 8 + (lane >> 3), ch = lane & 7; const LAS f32x4* sp = (const LAS f32x4*)(ost + rr * 64 + ch * 8); const f32x4 v0 = sp[0], v1 = sp[1];
            const int tk = rr & 7, h2 = g * 4 + (rr >> 3);
            *(u32x4*)(O + ((size_t)b * T + q0 + 8 * wid + tk) * 512 + h2 * 64 + ch * 8) = pg8::pack8(v0, v1); }
    }
#undef NSA_CTX
#undef NSA_DMA
#undef BR_BEGIN
#undef BR_END
}

__global__ void __launch_bounds__(NWAVES * 64, 2) fwd_kernel(Args a) {
    extern __shared__ __attribute__((aligned(16))) unsigned char lds_raw[];
    cg::grid_group grid = cg::this_grid();
    Frame F; F.lds = (LAS unsigned char*)lds_raw; F.tid = threadIdx.x; F.lane = F.tid & 63; F.wave = __builtin_amdgcn_readfirstlane(F.tid >> 6); F.G = gridDim.x; F.bid = blockIdx.x;
    unsigned char* ws = a.ws;
    const int lo = a.ph_lo, hi = a.ph_hi;
#ifndef PH_MASK
#define PH_MASK 0x1ff
#endif
#define IN(k) (((PH_MASK >> (k)) & 1) && lo <= (k) && (k) < hi)
    volatile LAS unsigned* MISC = (volatile LAS unsigned*)(F.lds + L_MISC);
    if (F.tid < 16) MISC[F.tid] = 0u;
    __syncthreads();
    const XcdBarrier xbar = xcd_barrier_post((unsigned*)(ws + WS_BAR), MISC);
#define SEAM(k) do { if (IN(k) && IN((k) + 1)) { if ((k) == 0) grid.sync(); else xcd_barrier(xbar); } } while (0)
    if (IN(0)) { p0_prologue(F, a); } SEAM(0);
    if (IN(1)) {
        pg8::Gemm g{(const bf16_t*)(ws + WS_XN), nullptr, (const bf16_t*)(ws + WS_WIN), nullptr, M, NIN, D};
        pg8::StaticOrder S; S.init(M, NIN, F.G, F.bid, 0);
        pg8::EpiQKV E{(bf16_t*)(ws + WS_FQ), (bf16_t*)(ws + WS_FK), (bf16_t*)(ws + WS_FV), (bf16_t*)(ws + WS_NQ), (bf16_t*)(ws + WS_KV6), (bf16_t*)(ws + WS_GA), (bf16_t*)(ws + WS_GB), (float*)(ws + WS_SMALL)};
        pg8::gemm_phase<pg8::EpiQKV, true, true>(F.lds, g, S, E);
    } SEAM(1);
    if (IN(2)) {
        for (int u = F.bid; u < 64; u += F.G) compress_unit(F, a, u);
        for (int s = 0; s < 32; ++s) if (((s + 64) % F.G) == F.bid && F.wave == 0) scan_seq(a, s, F.lane);
    } SEAM(2);
    if (IN(3)) {
        for (int v = F.bid; v < 256; v += F.G) {
#ifndef NO_FOX
            { const int bh = v >> 3, s = v & 7; for (int k = 0; k < 2; ++k) fox_unit(F, a, bh >> 3, bh & 7, k ? 15 - s : s); }
#endif
#ifndef NO_NSA
            { const int bg = v >> 5, s = v & 31; for (int k = 0; k < 2; ++k) nsa_unit(F, a, bg, k ? 63 - s : s); }
#endif
        }
        __syncthreads();
    } SEAM(3);
    if (IN(4)) {
        pg8::Gemm g{(const bf16_t*)(ws + WS_OFOX), (const bf16_t*)(ws + WS_ONSA), (const bf16_t*)(ws + WS_WF), (const bf16_t*)(ws + WS_WN), M, D, 512};
        pg8::StaticOrder S; S.init(M, D, F.G, F.bid, 1);
        pg8::EpiMerge E{(const bf16_t*)(ws + WS_GA), (const bf16_t*)(ws + WS_GB), (bf16_t*)(ws + WS_MERGED)};
        pg8::gemm_phase<pg8::EpiMerge, true, true>(F.lds, g, S, E);
    } SEAM(4);
    if (IN(5)) {
        pg8::Gemm g{(const bf16_t*)(ws + WS_MERGED), nullptr, (const bf16_t*)(ws + WS_WOUT), nullptr, M, D, D};
        pg8::StaticOrder S; S.init(M, D, F.G, F.bid, 0);
        pg8::EpiRes E{a.x, a.out, (bf16_t*)(ws + WS_XN), (float*)(ws + WS_SSQ1)};
        pg8::gemm_phase<pg8::EpiRes, true, true>(F.lds, g, S, E);
    } SEAM(5);
    if (IN(6)) {
        pg8::Gemm g{(const bf16_t*)(ws + WS_XN), nullptr, (const bf16_t*)(ws + WS_W1), nullptr, M, FF, D};
        pg8::StaticOrder S; S.init(M, FF, F.G, F.bid, 0);
        pg8::EpiFF1 E{(const float*)(ws + WS_SSQ1), (bf16_t*)(ws + WS_H)};
        pg8::gemm_phase<pg8::EpiFF1, true, true>(F.lds, g, S, E);
    } SEAM(6);
    if (IN(7)) {
        pg8::Gemm g{(const bf16_t*)(ws + WS_H), nullptr, (const bf16_t*)(ws + WS_W2), nullptr, M, D, FF};
        pg8::StaticOrder S; S.init(M, D, F.G, F.bid, 0);
        pg8::EpiRes E{a.out, a.out, nullptr, (float*)(ws + WS_SSQ2)};
        pg8::gemm_phase<pg8::EpiRes, true, true>(F.lds, g, S, E);
    } SEAM(7);
    if (IN(8)) {
        const int gw = F.bid * NWAVES + F.wave, NGW = F.G * NWAVES;
        const f32x4* gp = (const f32x4*)a.g_final + F.lane; f32x4 gv[4];
#pragma unroll
        for (int j = 0; j < 4; ++j) gv[j] = gp[64 * j];
        for (int m = gw; m < M; m += NGW) {
            const f32x4* sp = (const f32x4*)((const float*)(ws + WS_SSQ2) + (size_t)m * 16); const f32x4 s = (sp[0] + sp[1]) + (sp[2] + sp[3]);
            const float rstd = 1.0f / sqrtf(((s[0] + s[1]) + (s[2] + s[3])) * (1.0f / D) + RMS_EPS);
            f32x4* xr = (f32x4*)(a.out + (size_t)m * D) + F.lane;
#pragma unroll
            for (int j = 0; j < 4; ++j) xr[64 * j] = xr[64 * j] * rstd * gv[j];
        }
    }
#undef IN
#undef SEAM
}

#ifndef N_LAUNCHES
#define N_LAUNCHES 1
#endif
extern "C" void kernel_launch(void* const* d_in, const int* in_sizes, int n_in, void* d_out, int out_size, void* d_ws, size_t ws_size, hipStream_t stream) {
    static int grid = 0;
    if (grid == 0) {
        if (n_in != 18 || in_sizes[0] != M * D || out_size != M * D || ws_size < WS_END) { fprintf(stderr, "kernel_launch: unexpected shapes (n_in %d, in0 %d, out %d, ws %zu)\n", n_in, n_in > 0 ? in_sizes[0] : -1, out_size, ws_size); grid = -1; return; }
        int dev = 0, cus = 0, per_cu = 0;
        if (hipGetDevice(&dev) != hipSuccess || hipDeviceGetAttribute(&cus, hipDeviceAttributeMultiprocessorCount, dev) != hipSuccess) { grid = -1; return; }
        if (hipFuncSetAttribute((const void*)fwd_kernel, hipFuncAttributeMaxDynamicSharedMemorySize, LDS_BYTES) != hipSuccess) { fprintf(stderr, "hipFuncSetAttribute failed\n"); grid = -1; return; }
        if (hipOccupancyMaxActiveBlocksPerMultiprocessor(&per_cu, (const void*)fwd_kernel, NWAVES * 64, LDS_BYTES) != hipSuccess || per_cu < 1) { fprintf(stderr, "occupancy query: %d blocks/CU\n", per_cu); grid = -1; (void)hipGetLastError(); return; }
        grid = cus;
    }
    if (grid < 0) return;
    (void)hipMemsetAsync((char*)d_ws + WS_CTL, 0, CTL_ZERO_BYTES, stream);
    Args a{};
    const float** p = (const float**)&a;
    for (int i = 0; i < 18; ++i) p[i] = (const float*)d_in[i];
    a.out = (float*)d_out; a.ws = (unsigned char*)d_ws;
    constexpr int NPH = 9;
    for (int li = 0; li < N_LAUNCHES; ++li) {
        a.ph_lo = (N_LAUNCHES == 1) ? 0 : li; a.ph_hi = (N_LAUNCHES == 1) ? NPH : li + 1;
        void* args[] = {&a};
        hipError_t e = hipLaunchCooperativeKernel((void*)fwd_kernel, dim3(grid), dim3(NWAVES * 64), args, LDS_BYTES, stream);
        if (e != hipSuccess) { fprintf(stderr, "cooperative launch failed: %s (grid %d)\n", hipGetErrorString(e), grid); break; }
    }
}
```

```cpp
#include <hip/hip_runtime.h>
#include <hip/hip_cooperative_groups.h>
#include <hip/hip_bf16.h>
#include <cstdio>
#include <cstdint>
#include <cmath>
namespace cg = cooperative_groups;

#define LAS __attribute__((address_space(3)))
#define GAS __attribute__((address_space(1)))
typedef unsigned short bf16_t;
typedef short bf16x8 __attribute__((ext_vector_type(8)));
typedef short s16x4 __attribute__((ext_vector_type(4)));
typedef float f32x4 __attribute__((ext_vector_type(4)));
typedef float f32x2 __attribute__((ext_vector_type(2)));
typedef float f32x16 __attribute__((ext_vector_type(16)));
typedef unsigned u32x4 __attribute__((ext_vector_type(4)));
typedef unsigned u32x2 __attribute__((ext_vector_type(2)));
typedef __bf16 bf16x2_t __attribute__((ext_vector_type(2)));

constexpr int BATCH = 4, T = 4096, D = 1024, M = BATCH * T, FF = 4096;
constexpr int NIN = 5120;
constexpr int NKV = 2, NH = 8, HD = 64;
constexpr float RMS_EPS = 1e-6f;
constexpr float LOG2E = 1.4426950408889634f;
constexpr float C2 = 0.125f * LOG2E;
constexpr float NEGBIG = -1.0e30f;
constexpr int NWAVES = 8;

constexpr size_t MiB = 1u << 20;
constexpr size_t WS_CTL = 0, CTL_ZERO_BYTES = 64 * 1024;
constexpr size_t WS_BAR = 16384;
constexpr size_t WS_CB1 = 1 * MiB + 128 * 1024;
constexpr size_t WS_LUT = 1 * MiB;
constexpr size_t WS_CW2T = 1 * MiB + 64 * 1024;
constexpr size_t WS_SSQ1 = 2 * MiB, WS_SSQ2 = 3 * MiB;
constexpr size_t WS_WIN = 4 * MiB;
constexpr size_t WS_WF = 14 * MiB, WS_WN = 15 * MiB;
constexpr size_t WS_WOUT = 16 * MiB;
constexpr size_t WS_W1 = 18 * MiB, WS_W2 = 26 * MiB;
constexpr size_t WS_CW1 = 34 * MiB;
constexpr size_t WS_KC = 36 * MiB;
constexpr size_t WS_FB = 37 * MiB;
constexpr size_t WS_SMALL = 41 * MiB;
constexpr size_t WS_XN = 44 * MiB;
constexpr size_t WS_OFOX = 44 * MiB, WS_ONSA = 60 * MiB;
constexpr size_t WS_FQ = 76 * MiB, WS_FK = 92 * MiB, WS_FV = 108 * MiB, WS_NQ = 124 * MiB;
constexpr size_t WS_KV6 = 140 * MiB;
constexpr size_t KV6_ELEMS = (size_t)BATCH * NKV * T * HD;
constexpr size_t WS_GA = 165 * MiB, WS_GB = 197 * MiB;
constexpr size_t WS_MERGED = 76 * MiB;
constexpr size_t WS_H = 76 * MiB;
constexpr size_t WS_END = 229 * MiB;

constexpr int LDS_BYTES = 147456;
constexpr int KSLOT = 10240, VSLOT = 8192;
constexpr int L_K = 0, L_V = 2 * KSLOT, L_WSF = L_V + 2 * VSLOT, L_OST = L_WSF + 2048, L_LUT = L_OST + 8 * 8192, L_ATT_END = L_LUT + 4 * 384 * 4;
static_assert(L_ATT_END <= 131072, "attention LDS");
constexpr int L_MISC = 131072;

__device__ __forceinline__ unsigned cvtpk(float lo, float hi) { f32x2 v = {lo, hi}; bf16x2_t b = __builtin_convertvector(v, bf16x2_t); return __builtin_bit_cast(unsigned, b); }
__device__ __forceinline__ float bf_lo(unsigned w) { return __uint_as_float(w << 16); }
__device__ __forceinline__ float bf_hi(unsigned w) { return __uint_as_float(w & 0xffff0000u); }
__device__ __forceinline__ float fsigmoid(float x) { return __builtin_amdgcn_rcpf(1.0f + __builtin_amdgcn_exp2f(-x * LOG2E)); }
__device__ __forceinline__ int crow(int r, int hi) { return (r & 3) + 8 * (r >> 2) + 4 * hi; }
#define SBAR() __builtin_amdgcn_sched_barrier(0)
#define OPAQUE(x) asm volatile("" : "+v"(x))
#define LDS_WAIT() asm volatile("s_waitcnt lgkmcnt(0)" ::: "memory")
#define VM_WAIT() asm volatile("s_waitcnt vmcnt(0)" ::: "memory")

namespace pg8 {
constexpr int BM = 256, BK = 64, HALF = 128, HTB = HALF * BK * 2, STAGE_BYTES = 8 * HTB, NXCD = 8, WGM = 8;
__host__ __device__ __forceinline__ int lds_byte(int r, int c) { const int st = (r >> 4) * 2 + (c >> 5), rr = r & 15, cc = c & 31, ob = rr * 64 + cc * 2; return st * 1024 + (ob ^ (((ob >> 9) & 1) << 5)); }
__host__ __device__ __forceinline__ void stage_rc(int b, int& R, int& C) { const int st = b / 1024, sb = b % 1024, swz = sb ^ (((sb >> 9) & 1) << 5); R = (st >> 1) * 16 + swz / 64; C = (st & 1) * 32 + (swz % 64) / 2; }
__host__ __device__ __forceinline__ int perm32(int rho) { const int n = rho >> 4, i = rho & 15; return 8 * (i >> 2) + 4 * n + (i & 3); }

struct Unit { int pm, pn, w; };
struct Gemm { const bf16_t* A0; const bf16_t* A1; const bf16_t* B0; const bf16_t* B1; int M, N, K; };

struct StaticOrder {
    int nM, nN, nwg, G, c, dual;
    __device__ void init(int M_, int N_, int G_, int c_, int dual_) { nM = M_ / BM; nN = N_ / BM; nwg = nM * nN; G = G_; c = c_; dual = dual_; }
    __device__ bool next(int i, Unit& u) const {
        const int ti = dual ? (i >> 1) : i; u.w = dual ? (i & 1) : 0;
        const long L = (long)ti * G + c; if (L >= nwg) return false;
        int wgid = (int)L; { const int q = nwg / NXCD, r = nwg % NXCD, xcd = wgid % NXCD, off = wgid / NXCD; wgid = (xcd < r ? xcd * (q + 1) : r * (q + 1) + (xcd - r) * q) + off; }
        const int nig = WGM * nN, gid = wgid / nig, fm = gid * WGM, gsz = (nM - fm) < WGM ? (nM - fm) : WGM;
        u.pm = fm + ((wgid % nig) % gsz); u.pn = (wgid % nig) / gsz; return true;
    }
};

typedef f32x4 Acc[2][2][4][2];

template <class Epi, bool ALIGN_EPI, bool SP2>
__device__ __forceinline__ void gemm_phase(LAS unsigned char* lds, const Gemm g, const StaticOrder& S, const Epi& E) {
    const int tid = threadIdx.x, wid = __builtin_amdgcn_readfirstlane(tid >> 6), lane = tid & 63, wr = wid >> 2, wc = wid & 3, fr = lane & 15, fq = lane >> 4;
    const int K = g.K, nt = K / BK;
    unsigned voffA[2], voffB[2];
#pragma unroll
    for (int i = 0; i < 2; ++i) { int R, C; stage_rc(tid * 16 + i * 8192, R, C); const int Rb = Epi::PERM ? ((R & ~31) + perm32(R & 31)) : R;
        voffA[i] = (unsigned)(R * K + C) * 2u; voffB[i] = (unsigned)(Rb * K + C) * 2u; }
    const size_t kstep = (size_t)(BK * 2);
    const size_t hstep = (size_t)HALF * K * 2;
    const size_t tstep = 2 * hstep;
    const unsigned ldsw = (unsigned)wid * 1024u;
    const int aoff = lds_byte(wr * 64 + fr, fq * 8), boff = lds_byte(wc * 32 + fr, fq * 8);
#define PG8_SA(b, h) (((b) * 2 + (h)) * HTB)
#define PG8_SB(b, h) ((4 + (b) * 2 + (h)) * HTB)
#define PG8_STAGE(bufoff, gbase, voff) do { _Pragma("unroll") for (int _i = 0; _i < 2; ++_i) \
        __builtin_amdgcn_global_load_lds((const unsigned*)((const char*)(gbase) + (voff)[_i]), (LAS unsigned*)(lds + (bufoff) + ldsw + _i * 8192), 16, 0, 0); } while (0)
#define PG8_LDA(dst, b, h) do { _Pragma("unroll") for (int m = 0; m < 4; ++m) _Pragma("unroll") for (int k = 0; k < 2; ++k) dst[m][k] = *(const LAS bf16x8*)(lds + PG8_SA(b, h) + aoff + m * 2048 + k * 1024); } while (0)
#define PG8_LDB(dst, b, h) do { _Pragma("unroll") for (int n = 0; n < 2; ++n) _Pragma("unroll") for (int k = 0; k < 2; ++k) dst[n][k] = *(const LAS bf16x8*)(lds + PG8_SB(b, h) + boff + n * 2048 + k * 1024); } while (0)
#define PG8_MMA(ai, bj, At, Bt) do { __builtin_amdgcn_s_setprio(1); _Pragma("unroll") for (int m = 0; m < 4; ++m) _Pragma("unroll") for (int n = 0; n < 2; ++n) _Pragma("unroll") for (int k = 0; k < 2; ++k) \
        acc[ai][bj][m][n] = __builtin_amdgcn_mfma_f32_16x16x32_bf16(Bt[n][k], At[m][k], acc[ai][bj][m][n], 0, 0, 0); __builtin_amdgcn_s_setprio(0); } while (0)
#define PG8_WAIT_V(n) asm volatile("s_waitcnt vmcnt(" #n ")" ::: "memory")
#define PG8_WAIT_L(n) asm volatile("s_waitcnt lgkmcnt(" #n ")" ::: "memory")
#define PG8_BAR __builtin_amdgcn_s_barrier()
#define PG8_SCHED __builtin_amdgcn_sched_barrier(0)
    Unit cur, nxt; int ui = 0;
    if (!S.next(0, cur)) return;
    Acc acc;
#pragma unroll
    for (int a = 0; a < 2; ++a)
#pragma unroll
        for (int b = 0; b < 2; ++b)
#pragma unroll
            for (int m = 0; m < 4; ++m)
#pragma unroll
                for (int n = 0; n < 2; ++n) acc[a][b][m][n] = (f32x4){0.f, 0.f, 0.f, 0.f};
    bf16x8 At[4][2], B0[2][2], B1[2][2];
    const char* cA = (const char*)(cur.w ? g.A1 : g.A0) + (size_t)cur.pm * tstep; const char* cB = (const char*)(cur.w ? g.B1 : g.B0) + (size_t)cur.pn * tstep;
    if constexpr (SP2) {
        PG8_STAGE(PG8_SB(0, 0), cB, voffB); PG8_STAGE(PG8_SB(0, 1), cB + hstep, voffB); PG8_STAGE(PG8_SA(0, 0), cA, voffA); PG8_STAGE(PG8_SA(0, 1), cA + hstep, voffA);
        if (wr == 1) PG8_BAR;
        PG8_WAIT_V(2); PG8_BAR;
        PG8_STAGE(PG8_SB(1, 0), cB + kstep, voffB); PG8_STAGE(PG8_SA(1, 0), cA + kstep, voffA); PG8_STAGE(PG8_SB(1, 1), cB + hstep + kstep, voffB);
        PG8_WAIT_V(6); PG8_BAR;
    } else {
        PG8_STAGE(PG8_SB(0, 0), cB, voffB); PG8_STAGE(PG8_SA(0, 0), cA, voffA); PG8_STAGE(PG8_SB(0, 1), cB + hstep, voffB); PG8_STAGE(PG8_SA(0, 1), cA + hstep, voffA);
        if (wr == 1) PG8_BAR;
        PG8_WAIT_V(4); PG8_BAR;
        PG8_STAGE(PG8_SB(1, 0), cB + kstep, voffB); PG8_STAGE(PG8_SA(1, 0), cA + kstep, voffA); PG8_STAGE(PG8_SB(1, 1), cB + hstep + kstep, voffB);
        PG8_WAIT_V(6); PG8_BAR;
    }
    for (;;) {
        const bool has_next = S.next(ui + 1, nxt);
        const char* nA = has_next ? (const char*)(nxt.w ? g.A1 : g.A0) + (size_t)nxt.pm * tstep : cA; const char* nB = has_next ? (const char*)(nxt.w ? g.B1 : g.B0) + (size_t)nxt.pn * tstep : cB;
        for (int t = 0; t < nt; t += 2) {
            const bool last = (t == nt - 2);
            const char* a1 = cA + (size_t)(t + 1) * kstep;
            const char* a2 = last ? nA : cA + (size_t)(t + 2) * kstep; const char* b2 = last ? nB : cB + (size_t)(t + 2) * kstep;
            const char* a3 = a2 + kstep; const char* b3 = b2 + kstep;
            if constexpr (SP2) {
            PG8_LDB(B0, 0, 0); PG8_LDB(B1, 0, 1); PG8_SCHED; PG8_LDA(At, 0, 0); PG8_STAGE(PG8_SA(1, 1), a1 + hstep, voffA);
            PG8_WAIT_V(8); PG8_WAIT_L(0); PG8_BAR; PG8_MMA(0, 0, At, B0); PG8_MMA(0, 1, At, B1); PG8_BAR; PG8_SCHED;
            PG8_LDA(At, 0, 1); PG8_STAGE(PG8_SB(0, 0), b2, voffB); PG8_STAGE(PG8_SB(0, 1), b2 + hstep, voffB); PG8_STAGE(PG8_SA(0, 0), a2, voffA);
            PG8_WAIT_V(8); PG8_WAIT_L(0); PG8_BAR; PG8_MMA(1, 0, At, B0); PG8_MMA(1, 1, At, B1); PG8_BAR; PG8_SCHED;
            PG8_LDB(B0, 1, 0); PG8_LDB(B1, 1, 1); PG8_SCHED; PG8_LDA(At, 1, 0); PG8_STAGE(PG8_SA(0, 1), a2 + hstep, voffA);
            PG8_WAIT_V(8); PG8_WAIT_L(0); PG8_BAR; PG8_MMA(0, 0, At, B0); PG8_MMA(0, 1, At, B1); PG8_BAR; PG8_SCHED;
            PG8_LDA(At, 1, 1); PG8_STAGE(PG8_SB(1, 0), b3, voffB); PG8_STAGE(PG8_SB(1, 1), b3 + hstep, voffB); PG8_STAGE(PG8_SA(1, 0), a3, voffA);
            PG8_WAIT_V(8); PG8_WAIT_L(0); PG8_BAR; PG8_MMA(1, 0, At, B0); PG8_MMA(1, 1, At, B1); PG8_BAR; PG8_SCHED;
            } else {
            PG8_LDB(B0, 0, 0); PG8_SCHED; PG8_LDA(At, 0, 0); PG8_STAGE(PG8_SA(1, 1), a1 + hstep, voffA);
            PG8_WAIT_L(8); PG8_BAR; PG8_WAIT_L(0); PG8_MMA(0, 0, At, B0); PG8_BAR; PG8_SCHED;
            PG8_LDB(B1, 0, 1); PG8_STAGE(PG8_SB(0, 0), b2, voffB);
            PG8_BAR; PG8_WAIT_L(0); PG8_MMA(0, 1, At, B1); PG8_BAR;
            PG8_LDA(At, 0, 1); PG8_STAGE(PG8_SA(0, 0), a2, voffA);
            PG8_BAR; PG8_WAIT_L(0); PG8_MMA(1, 0, At, B0); PG8_BAR; PG8_SCHED;
            PG8_STAGE(PG8_SB(0, 1), b2 + hstep, voffB);
            PG8_WAIT_V(6); PG8_BAR; PG8_MMA(1, 1, At, B1); PG8_BAR;
            PG8_LDB(B0, 1, 0); PG8_SCHED; PG8_LDA(At, 1, 0); PG8_STAGE(PG8_SA(0, 1), a2 + hstep, voffA);
            PG8_WAIT_L(8); PG8_BAR; PG8_WAIT_L(0); PG8_MMA(0, 0, At, B0); PG8_BAR; PG8_SCHED;
            PG8_LDB(B1, 1, 1); PG8_STAGE(PG8_SB(1, 0), b3, voffB);
            PG8_BAR; PG8_WAIT_L(0); PG8_MMA(0, 1, At, B1); PG8_BAR;
            PG8_LDA(At, 1, 1); PG8_STAGE(PG8_SA(1, 0), a3, voffA);
            PG8_BAR; PG8_WAIT_L(0); PG8_MMA(1, 0, At, B0); PG8_BAR; PG8_SCHED;
            PG8_STAGE(PG8_SB(1, 1), b3 + hstep, voffB);
            PG8_WAIT_V(6); PG8_BAR; PG8_MMA(1, 1, At, B1); PG8_BAR;
            }
        }
        if constexpr (ALIGN_EPI) { if (wr == 0) PG8_BAR; }
        const bool keep = Epi::DUAL && (cur.w == 0);
        if (keep) E.mid(acc, cur, wr, wc, fr, fq); else E(acc, cur, wr, wc, fr, fq);
        if (!has_next) break;
        if (!keep) {
#pragma unroll
        for (int a = 0; a < 2; ++a)
#pragma unroll
            for (int b = 0; b < 2; ++b)
#pragma unroll
                for (int m = 0; m < 4; ++m)
#pragma unroll
                    for (int n = 0; n < 2; ++n) acc[a][b][m][n] = (f32x4){0.f, 0.f, 0.f, 0.f};
        }
        cur = nxt; cA = nA; cB = nB; ++ui;
        if constexpr (ALIGN_EPI) { if (wr == 1) PG8_BAR; }
    }
    PG8_WAIT_V(0);
    if constexpr (!ALIGN_EPI) { if (wr == 0) PG8_BAR; }
    PG8_BAR;
#undef PG8_SA
#undef PG8_SB
#undef PG8_STAGE
#undef PG8_LDA
#undef PG8_LDB
#undef PG8_MMA
#undef PG8_WAIT_V
#undef PG8_WAIT_L
#undef PG8_BAR
#undef PG8_SCHED
}

__device__ __forceinline__ u32x4 pack8(f32x4 v0, f32x4 v1) { u32x4 w; w.x = cvtpk(v0[0], v0[1]); w.y = cvtpk(v0[2], v0[3]); w.z = cvtpk(v1[0], v1[1]); w.w = cvtpk(v1[2], v1[3]); return w; }

struct EpiQKV {
    static constexpr bool PERM = true, DUAL = false;
    bf16_t *FQ, *FK, *FV, *NQ, *KV6, *GA, *GB; float* SMALL;
    __device__ __forceinline__ void mid(Acc& acc, const Unit& u, int wr, int wc, int fr, int fq) const {}
    __device__ __forceinline__ void operator()(const Acc& acc, const Unit& u, int wr, int wc, int fr, int fq) const {
        const int pn = u.pn, row0 = u.pm * BM + wr * 64 + fr, cl = wc * 32 + 8 * fq;
#pragma unroll
        for (int ai = 0; ai < 2; ++ai)
#pragma unroll
            for (int m = 0; m < 4; ++m) { const int row = row0 + ai * HALF + m * 16;
#pragma unroll
                for (int bj = 0; bj < 2; ++bj) { f32x4 v0 = acc[ai][bj][m][0], v1 = acc[ai][bj][m][1]; const int c = bj * HALF + cl;
                    if (pn < 8) { bf16_t* base = FQ + (size_t)(pn >> 1) * (8u << 20); const float sc = (pn < 2 || pn >= 6) ? C2 : 1.f;
                        *(u32x4*)(base + (size_t)row * 512 + (pn & 1) * 256 + c) = pack8(v0 * sc, v1 * sc);
                    } else if (pn < 11) { const int n6 = (pn - 8) * 256 + c, which = n6 >> 7, gg = (n6 >> 6) & 1, d = n6 & 63, b = row >> 12, t = row & 4095;
                        *(u32x4*)(KV6 + (size_t)which * KV6_ELEMS + ((size_t)((b * 2 + gg) * T + t) * 64 + d)) = pack8(v0, v1);
                    } else if (pn < 19) { bf16_t* base = GA + (size_t)((pn - 11) >> 2) * (16u << 20); const int col = ((pn - 11) & 3) * 256 + c;
                        f32x4 s0, s1;
#pragma unroll
                        for (int e = 0; e < 4; ++e) { s0[e] = fsigmoid(v0[e]); s1[e] = fsigmoid(v1[e]); }
                        *(u32x4*)(base + (size_t)row * 1024 + col) = pack8(s0, s1);
                    } else { if (c < 32) { *(f32x4*)(SMALL + (size_t)row * 32 + c) = v0; *(f32x4*)(SMALL + (size_t)row * 32 + c + 4) = v1; } }
                } }
    }
};
struct EpiMerge {
    static constexpr bool PERM = true, DUAL = true;
    const bf16_t *GA, *GB; bf16_t* OUT;
    __device__ __forceinline__ void mid(Acc& acc, const Unit& u, int wr, int wc, int fr, int fq) const {
        const int row0 = u.pm * BM + wr * 64 + fr, col0 = u.pn * BM + wc * 32 + 8 * fq;
#pragma unroll
        for (int ai = 0; ai < 2; ++ai)
#pragma unroll
            for (int m = 0; m < 4; ++m) { const size_t ro = (size_t)(row0 + ai * HALF + m * 16) * 1024 + col0;
#pragma unroll
                for (int bj = 0; bj < 2; ++bj) { const u32x4 a = *(const u32x4*)(GA + ro + bj * HALF), b = *(const u32x4*)(GB + ro + bj * HALF);
                    f32x4 r0, r1;
                    r0[0] = bf_lo(a.x) * __builtin_amdgcn_rcpf(bf_lo(b.x)); r0[1] = bf_hi(a.x) * __builtin_amdgcn_rcpf(bf_hi(b.x));
                    r0[2] = bf_lo(a.y) * __builtin_amdgcn_rcpf(bf_lo(b.y)); r0[3] = bf_hi(a.y) * __builtin_amdgcn_rcpf(bf_hi(b.y));
                    r1[0] = bf_lo(a.z) * __builtin_amdgcn_rcpf(bf_lo(b.z)); r1[1] = bf_hi(a.z) * __builtin_amdgcn_rcpf(bf_hi(b.z));
                    r1[2] = bf_lo(a.w) * __builtin_amdgcn_rcpf(bf_lo(b.w)); r1[3] = bf_hi(a.w) * __builtin_amdgcn_rcpf(bf_hi(b.w));
                    acc[ai][bj][m][0] *= r0; acc[ai][bj][m][1] *= r1; } }
    }
    __device__ __forceinline__ void operator()(const Acc& acc, const Unit& u, int wr, int wc, int fr, int fq) const {
        const int row0 = u.pm * BM + wr * 64 + fr, col0 = u.pn * BM + wc * 32 + 8 * fq;
#pragma unroll
        for (int ai = 0; ai < 2; ++ai)
#pragma unroll
            for (int m = 0; m < 4; ++m) { const size_t ro = (size_t)(row0 + ai * HALF + m * 16) * 1024 + col0;
#pragma unroll
                for (int bj = 0; bj < 2; ++bj) { const u32x4 b = *(const u32x4*)(GB + ro + bj * HALF);
                    const f32x4 g0 = {bf_lo(b.x), bf_hi(b.x), bf_lo(b.y), bf_hi(b.y)}, g1 = {bf_lo(b.z), bf_hi(b.z), bf_lo(b.w), bf_hi(b.w)};
                    *(u32x4*)(OUT + ro + bj * HALF) = pack8(acc[ai][bj][m][0] * g0, acc[ai][bj][m][1] * g1); } }
    }
};
struct EpiRes {
    static constexpr bool PERM = false, DUAL = false;
    const float* base; float* out; bf16_t* xb; float* ssqp;
    __device__ __forceinline__ void mid(Acc& acc, const Unit& u, int wr, int wc, int fr, int fq) const {}
    __device__ __forceinline__ void operator()(const Acc& acc, const Unit& u, int wr, int wc, int fr, int fq) const {
        const int row0 = u.pm * BM + wr * 64 + fr, col0 = u.pn * BM + wc * 32 + 4 * fq;
#pragma unroll
        for (int ai = 0; ai < 2; ++ai)
#pragma unroll
            for (int m = 0; m < 4; ++m) { const int row = row0 + ai * HALF + m * 16; const size_t ro = (size_t)row * 1024 + col0; float ss = 0.f;
#pragma unroll
                for (int bj = 0; bj < 2; ++bj)
#pragma unroll
                    for (int n = 0; n < 2; ++n) { const size_t o = ro + bj * HALF + n * 16; const f32x4 v = *(const f32x4*)(base + o) + acc[ai][bj][m][n];
                        *(f32x4*)(out + o) = v; ss += (v[0] * v[0] + v[1] * v[1]) + (v[2] * v[2] + v[3] * v[3]);
                        if (xb) { u32x2 w; w.x = cvtpk(v[0], v[1]); w.y = cvtpk(v[2], v[3]); *(u32x2*)(xb + o) = w; } }
                ss += __shfl_xor(ss, 16); ss += __shfl_xor(ss, 32);
                if (fq == 0) ssqp[(size_t)row * 16 + u.pn * 4 + wc] = ss; }
    }
};
struct EpiFF1 {
    static constexpr bool PERM = true, DUAL = false;
    const float* ssqp; bf16_t* H;
    __device__ __forceinline__ void mid(Acc& acc, const Unit& u, int wr, int wc, int fr, int fq) const {}
    __device__ __forceinline__ void operator()(const Acc& acc, const Unit& u, int wr, int wc, int fr, int fq) const {
        const int row0 = u.pm * BM + wr * 64 + fr, col0 = u.pn * BM + wc * 32 + 8 * fq;
#pragma unroll
        for (int ai = 0; ai < 2; ++ai)
#pragma unroll
            for (int m = 0; m < 4; ++m) { const int row = row0 + ai * HALF + m * 16;
                const f32x4* sp = (const f32x4*)(ssqp + (size_t)row * 16); const f32x4 s = (sp[0] + sp[1]) + (sp[2] + sp[3]);
                const float rstd = __builtin_amdgcn_rsqf(((s[0] + s[1]) + (s[2] + s[3])) * (1.0f / D) + RMS_EPS);
#pragma unroll
                for (int bj = 0; bj < 2; ++bj) { f32x4 v0 = acc[ai][bj][m][0] * rstd, v1 = acc[ai][bj][m][1] * rstd;
#pragma unroll
                    for (int e = 0; e < 4; ++e) { const float a = fmaxf(v0[e], 0.f), b = fmaxf(v1[e], 0.f); v0[e] = a * a; v1[e] = b * b; }
                    *(u32x4*)(H + (size_t)row * FF + col0 + bj * HALF) = pack8(v0, v1); } }
    }
};
}


#define XB_TMO      128
#define XB_XCNT(j)  (256  + 64 * (j))
#define XB_XSUB(j)  (1280 + 64 * (j))
#define XB_XGEN(j)  (2304 + 64 * (j))
#define XB_TOP      3328
#define XB_TOPGEN   3392
#define XCD_BAR_WORDS 3456
#define XB_SPIN_CAP (1u << 18)
__device__ __forceinline__ unsigned xb_ld(unsigned* p)              { return __hip_atomic_load(p, __ATOMIC_RELAXED, __HIP_MEMORY_SCOPE_AGENT); }
__device__ __forceinline__ unsigned xb_add(unsigned* p, unsigned v) { return __hip_atomic_fetch_add(p, v, __ATOMIC_RELAXED, __HIP_MEMORY_SCOPE_AGENT); }
__device__ __forceinline__ unsigned xb_xcc_id() { return (unsigned)__builtin_amdgcn_s_getreg((3 << 11) | 20) & 0xFu; }
#define XB_SPIN(cond, bar) do { unsigned _sp = 0; while (cond) { __builtin_amdgcn_s_sleep(1); \
    if ((++_sp & 255u) == 0u) { if (xb_ld(&(bar)[XB_TMO])) break; if (_sp > XB_SPIN_CAP) { atomicAdd(&(bar)[XB_TMO], 1u); break; } } } } while (0)
struct XcdBarrier { unsigned* bar; unsigned x; volatile LAS unsigned* st; };
__device__ __forceinline__ XcdBarrier xcd_barrier_post(unsigned* bar, volatile LAS unsigned* st) {
    XcdBarrier b; b.bar = bar; b.x = xb_xcc_id(); b.st = st;
    if (threadIdx.x == 0) (void)xb_add(&bar[XB_XCNT(b.x)], 1u);
    return b;
}
__device__ __forceinline__ void xcd_barrier_complete(unsigned* bar, unsigned x, unsigned& nloc, unsigned& nx) {
    const unsigned G = gridDim.x * gridDim.y * gridDim.z;
    unsigned sum, cnt, mine, sp = 0u;
    for (;;) {
        sum = 0u; cnt = 0u; mine = 0u;
#pragma unroll
        for (unsigned j = 0; j < 16; ++j) { const unsigned c = xb_ld(&bar[XB_XCNT(j)]); sum += c; cnt += (c > 0u) ? 1u : 0u; mine = (j == x) ? c : mine; }
        if (sum == G) break;
        __builtin_amdgcn_s_sleep(1);
        if ((++sp & 255u) == 0u) { if (xb_ld(&bar[XB_TMO])) break; if (sp > XB_SPIN_CAP) { atomicAdd(&bar[XB_TMO], 1u); break; } }
    }
    nloc = mine > 0u ? mine : 1u; nx = cnt > 0u ? cnt : 1u;
}
__device__ __forceinline__ void xcd_barrier(const XcdBarrier& b) {
    asm volatile("s_waitcnt vmcnt(0)" ::: "memory");
    __syncthreads();
    if (threadIdx.x == 0) {
        unsigned* bar = b.bar;
        __builtin_amdgcn_s_waitcnt(0);
        unsigned nloc = b.st[0], nx = b.st[1];
        if (nloc == 0u) { xcd_barrier_complete(bar, b.x, nloc, nx); b.st[0] = nloc; b.st[1] = nx; }
        const unsigned old = xb_add(&bar[XB_XSUB(b.x)], 1u);
        const unsigned gen = old / nloc;
        if (old + 1u == (gen + 1u) * nloc) {
            __builtin_amdgcn_fence(__ATOMIC_RELEASE, "agent");
            asm volatile("s_waitcnt vmcnt(0)" ::: "memory");
            const unsigned og = xb_add(&bar[XB_TOP], 1u);
            const unsigned tg = og / nx;
            if (og + 1u == (tg + 1u) * nx) xb_add(&bar[XB_TOPGEN], 1u);
            else XB_SPIN(xb_ld(&bar[XB_TOPGEN]) == tg, bar);
            __builtin_amdgcn_fence(__ATOMIC_ACQUIRE, "agent");
            xb_add(&bar[XB_XGEN(b.x)], 1u);
            asm volatile("s_waitcnt vmcnt(0)" ::: "memory");
        } else {
            XB_SPIN(xb_ld(&bar[XB_XGEN(b.x)]) == gen, bar);
            __builtin_amdgcn_fence(__ATOMIC_ACQUIRE, "agent");
            asm volatile("s_waitcnt vmcnt(0)" ::: "memory");
        }
    }
    __syncthreads();
}

struct Args {
    const float *x, *rel, *g_attn, *w_in, *b_forget, *pe_k, *cw1_k, *cw2_k, *pe_v, *cw1_v, *cw2_v, *w_br_fox, *w_br_nsa, *w_out, *g_mlp, *w_ff1, *w_ff2, *g_final;
    float* out; unsigned char* ws; int ph_lo, ph_hi, li, pad;
};
struct Frame { LAS unsigned char* lds; int tid, lane, wave, G, bid; };

__device__ __forceinline__ float wave_sum(float v) {
#pragma unroll
    for (int o = 1; o < 64; o <<= 1) v += __shfl_xor(v, o);
    return v;
}

__device__ __forceinline__ int win_srccol(int n) {
    if (n < 1536) return n; if (n < 2816) return n + 8; if (n < 4864) return n + 32;
    if (n < 4872) return n - 4864 + 1536; if (n < 4896) return n - 4872 + 2824; return -1;
}
template <bool MAP, bool FRAG = false>
__device__ __forceinline__ void transpose_item(const float* W, int K, int Nsrc, int nblk, bf16_t* WT, LAS float* scr, int item, int lane, const float* kscale) {
    const int kb = item / nblk, nb = item % nblk, k0 = 64 * kb, n0 = 32 * nb;
    const int nd = n0 + (lane & 31), ns = MAP ? win_srccol(nd) : nd;
#pragma unroll 8
    for (int i = 0; i < 32; ++i) { const int kk = 2 * i + (lane >> 5); float v = (ns >= 0) ? W[(size_t)(k0 + kk) * Nsrc + ns] : 0.f; if (kscale) v *= kscale[k0 + kk]; scr[kk * 33 + (lane & 31)] = v; }
    LDS_WAIT(); asm volatile("" ::: "memory");
    const int c = lane & 7;
#pragma unroll
    for (int j = 0; j < 4; ++j) { const int n = (lane >> 3) + 8 * j; const LAS float* s = scr + (8 * c) * 33 + n;
        u32x4 o; o.x = cvtpk(s[0 * 33], s[1 * 33]); o.y = cvtpk(s[2 * 33], s[3 * 33]); o.z = cvtpk(s[4 * 33], s[5 * 33]); o.w = cvtpk(s[6 * 33], s[7 * 33]);
        if (FRAG) { const int nn = n0 + n, kc = (k0 >> 3) + c; *(u32x4*)(WT + ((size_t)(((nn >> 5) * (K >> 4) + (kc >> 1)) * 64 + (kc & 1) * 32 + (nn & 31))) * 8) = o; }
        else *(u32x4*)(WT + (size_t)(n0 + n) * K + k0 + 8 * c) = o; }
    LDS_WAIT(); asm volatile("" ::: "memory");
}
__device__ __forceinline__ int rel_bucket(int n) {
    if (n < 16) return n;
    int lb = 16 + (int)(logf((float)n / 16.0f) / 2.0794415416798357f * 16.0f);
    return lb < 31 ? lb : 31;
}
__device__ __forceinline__ void p0_prologue(const Frame& F, const Args& a) {
    unsigned char* ws = a.ws;
    LAS float* scr = (LAS float*)(F.lds + F.wave * 16384);
    const int gw = F.bid * NWAVES + F.wave, NGW = F.G * NWAVES;
    constexpr int I_IN = 16 * 160, I_BR = 8 * 32, I_OUT = 16 * 32, I_1 = 16 * 128, I_2 = 64 * 32, I_C1 = 32 * 8, I_C2 = 4 * 2;
    constexpr int NITEMS = I_IN + 2 * I_BR + I_OUT + I_1 + I_2 + 2 * I_C1 + 2 * I_C2;
    for (int it = gw; it < NITEMS; it += NGW) {
        int r = it;
        if (r < I_IN) { transpose_item<true>(a.w_in, 1024, 4896, 160, (bf16_t*)(ws + WS_WIN), scr, r, F.lane, nullptr); continue; } r -= I_IN;
        if (r < I_BR) { transpose_item<false>(a.w_br_fox, 512, 1024, 32, (bf16_t*)(ws + WS_WF), scr, r, F.lane, nullptr); continue; } r -= I_BR;
        if (r < I_BR) { transpose_item<false>(a.w_br_nsa, 512, 1024, 32, (bf16_t*)(ws + WS_WN), scr, r, F.lane, nullptr); continue; } r -= I_BR;
        if (r < I_OUT) { transpose_item<false>(a.w_out, 1024, 1024, 32, (bf16_t*)(ws + WS_WOUT), scr, r, F.lane, nullptr); continue; } r -= I_OUT;
        if (r < I_1) { transpose_item<false>(a.w_ff1, 1024, 4096, 128, (bf16_t*)(ws + WS_W1), scr, r, F.lane, a.g_mlp); continue; } r -= I_1;
        if (r < I_2) { transpose_item<false>(a.w_ff2, 4096, 1024, 32, (bf16_t*)(ws + WS_W2), scr, r, F.lane, nullptr); continue; } r -= I_2;
        if (r < I_C1) { transpose_item<false, true>(a.cw1_k, 2048, 256, 8, (bf16_t*)(ws + WS_CW1), scr, r, F.lane, nullptr); continue; } r -= I_C1;
        if (r < I_C1) { transpose_item<false, true>(a.cw1_v, 2048, 256, 8, (bf16_t*)(ws + WS_CW1) + 256 * 2048, scr, r, F.lane, nullptr); continue; } r -= I_C1;
        if (r < I_C2) { transpose_item<false>(a.cw2_k, 256, 64, 2, (bf16_t*)(ws + WS_CW2T), scr, r, F.lane, nullptr); continue; } r -= I_C2;
        transpose_item<false>(a.cw2_v, 256, 64, 2, (bf16_t*)(ws + WS_CW2T) + 64 * 256, scr, r, F.lane, nullptr);
    }
    {
        bf16_t* XN = (bf16_t*)(ws + WS_XN);
        const f32x4* gp = (const f32x4*)a.g_attn + F.lane; f32x4 gv[4];
#pragma unroll
        for (int j = 0; j < 4; ++j) gv[j] = gp[64 * j];
        for (int m = gw; m < M; m += NGW) {
            const f32x4* xr = (const f32x4*)(a.x + (size_t)m * D) + F.lane; f32x4 v[4]; float s = 0.f;
#pragma unroll
            for (int j = 0; j < 4; ++j) { v[j] = xr[64 * j]; s += (v[j][0] * v[j][0] + v[j][1] * v[j][1]) + (v[j][2] * v[j][2] + v[j][3] * v[j][3]); }
            const float rstd = 1.0f / sqrtf(wave_sum(s) * (1.0f / D) + RMS_EPS);
            u32x2* o8 = (u32x2*)(XN + (size_t)m * D) + F.lane;
#pragma unroll
            for (int j = 0; j < 4; ++j) { const f32x4 y = v[j] * rstd * gv[j]; u32x2 w; w.x = cvtpk(y[0], y[1]); w.y = cvtpk(y[2], y[3]); o8[64 * j] = w; }
        }
    }
    for (int it = gw; it < 64; it += NGW) {
        const int kv = it >> 5, jb = (it >> 3) & 3, ic = it & 7; const float* pe = kv ? a.pe_v : a.pe_k; const float* w1 = kv ? a.cw1_v : a.cw1_k;
        const int j = jb * 64 + F.lane; float s = 0.f;
#pragma unroll 8
        for (int i = ic * 256; i < ic * 256 + 256; ++i) s += pe[i] * w1[(size_t)i * 256 + j];
        ((float*)(ws + WS_CB1))[(kv * 8 + ic) * 256 + j] = s;
    }
    for (int i = F.bid * 512 + F.tid; i < 8 * 384; i += F.G * 512) {
        const int h = i / 384, e = i % 384; float v;
        if (e < 256) { const int n = e - 64; v = (n < 0) ? NEGBIG : a.rel[rel_bucket(n < 128 ? n : 128) * 8 + h] * LOG2E; }
        else { const int n = 448 + (e - 256); v = (n < 512) ? a.rel[31 * 8 + h] * LOG2E : NEGBIG; }
        ((float*)(ws + WS_LUT))[i] = v;
    }
}

__device__ __forceinline__ float log_sigmoid_fast(float x) { return fminf(x, 0.f) - __logf(1.0f + __expf(-fabsf(x))); }
__device__ __forceinline__ void scan_seq(const Frame& F, const Args& a, int seq) {
    const int b = seq >> 3, h = seq & 7; const float bf = a.b_forget[h];
    const float* sm = (const float*)(a.ws + WS_SMALL) + ((size_t)b * T + F.tid * 8) * 32 + h;
    float v[8]; float tot = 0.f;
#pragma unroll
    for (int i = 0; i < 8; ++i) v[i] = sm[(size_t)i * 32];
#pragma unroll
    for (int i = 0; i < 8; ++i) { v[i] = log_sigmoid_fast(v[i] + bf); tot += v[i]; }
    float inc = tot;
#pragma unroll
    for (int o = 1; o < 64; o <<= 1) { const float t = __shfl_up(inc, o); if (F.lane >= o) inc += t; }
    LAS float* wt = (LAS float*)F.lds;
    __syncthreads();
    if (F.lane == 63) wt[F.wave] = inc;
    __syncthreads();
    float base = 0.f;
#pragma unroll
    for (int w = 0; w < 8; ++w) if (w < F.wave) base += wt[w];
    float run = base + inc - tot;
    u32x4* fb = (u32x4*)((bf16_t*)(a.ws + WS_FB) + ((size_t)seq * T + F.tid * 8) * 16);
#pragma unroll
    for (int i = 0; i < 8; ++i) {
        run += v[i];
        const float x = -run * LOG2E;
        const unsigned w0 = cvtpk(x, 0.f) & 0xffffu; const float r1 = x - __uint_as_float(w0 << 16);
        const unsigned w1 = cvtpk(r1, 0.f) & 0xffffu; const float r2 = r1 - __uint_as_float(w1 << 16);
        const unsigned w2 = cvtpk(r2, 0.f) & 0xffffu;
        fb[2 * i] = (u32x4){w0 | (w1 << 16), w2, 0u, 0u}; fb[2 * i + 1] = (u32x4){0u, 0u, 0u, 0u};
    }
    __syncthreads();
}
__device__ __forceinline__ void compress_unit(const Frame& F, const Args& a, int unit) {
    const int kv = unit >> 6, bg = (unit >> 3) & 7, ct = unit & 7, c0 = ct * 32;
    const int lane = F.lane, r32 = lane & 31, hi = lane >> 5, w = F.wave;
    const bf16_t* data = (const bf16_t*)(a.ws + WS_KV6) + (size_t)kv * KV6_ELEMS + (size_t)bg * T * 64;
    const bf16_t* w1t = (const bf16_t*)(a.ws + WS_CW1) + (size_t)kv * 256 * 2048;
    const bf16_t* w2t = (const bf16_t*)(a.ws + WS_CW2T) + (size_t)kv * 64 * 256;
    const float* cb1 = (const float*)(a.ws + WS_CB1) + kv * 2048;
    LAS float* red = (LAS float*)F.lds;
    for (int i = F.tid; i < 2048; i += 512) red[i] = 0.f;
    LAS unsigned char* xs = F.lds + 8192;
    { const u32x4* src = (const u32x4*)(data + (size_t)c0 * 1024);
      for (int ch = F.tid; ch < 33 * 128; ch += 512) { const u32x4 v = src[ch]; *(LAS u32x4*)(xs + (ch >> 7) * 2064 + (ch & 127) * 16) = v; } }
    const bf16_t* ap = w1t + ((size_t)w * 128 * 64 + lane) * 8;
    const LAS unsigned char* bp = xs + r32 * 2064 + hi * 16;
    f32x16 h0 = {};
    bf16x8 A0[8], A1[8];
#pragma unroll
    for (int j = 0; j < 8; ++j) A0[j] = *(const bf16x8*)(ap + j * 512);
    __syncthreads();
#pragma unroll 1
    for (int blk = 0; blk < 16; blk += 2) {
        const LAS unsigned char* b0p = bp + (blk >> 3) * 2064 + (blk & 7) * 256;
#pragma unroll
        for (int j = 0; j < 8; ++j) A1[j] = *(const bf16x8*)(ap + (blk * 8 + 8 + j) * 512);
#pragma unroll
        for (int j = 0; j < 8; ++j) h0 = __builtin_amdgcn_mfma_f32_32x32x16_bf16(A0[j], *(const LAS bf16x8*)(b0p + j * 32), h0, 0, 0, 0);
        if (blk + 2 < 16) {
#pragma unroll
            for (int j = 0; j < 8; ++j) A0[j] = *(const bf16x8*)(ap + (blk * 8 + 16 + j) * 512);
        }
#pragma unroll
        for (int j = 0; j < 8; ++j) h0 = __builtin_amdgcn_mfma_f32_32x32x16_bf16(A1[j], *(const LAS bf16x8*)(b0p + 256 + j * 32), h0, 0, 0, 0);
    }
#pragma unroll
    for (int r = 0; r < 16; ++r) { const float* cp = cb1 + 32 * w + crow(r, hi); float bj = 0.f;
#pragma unroll
        for (int ic = 0; ic < 8; ++ic) bj += cp[ic * 256];
        const float x0 = h0[r] + bj; h0[r] = x0 * fsigmoid(x0); }
    f32x16 po[2] = {};
#pragma unroll
    for (int s = 0; s < 2; ++s) {
        u32x4 t0;
        t0.x = cvtpk(h0[8 * s + 0], h0[8 * s + 1]); t0.y = cvtpk(h0[8 * s + 2], h0[8 * s + 3]); t0.z = cvtpk(h0[8 * s + 4], h0[8 * s + 5]); t0.w = cvtpk(h0[8 * s + 6], h0[8 * s + 7]);
        const bf16x8 xb0 = __builtin_bit_cast(bf16x8, t0);
#pragma unroll
        for (int dt = 0; dt < 2; ++dt) {
            const bf16_t* wp = w2t + (size_t)(dt * 32 + r32) * 256 + 32 * w + 16 * s + 4 * hi;
            const u32x2 lo = *(const u32x2*)wp, hi2 = *(const u32x2*)(wp + 8);
            const bf16x8 wa = __builtin_bit_cast(bf16x8, (u32x4){lo.x, lo.y, hi2.x, hi2.y});
            po[dt] = __builtin_amdgcn_mfma_f32_32x32x16_bf16(wa, xb0, po[dt], 0, 0, 0);
        }
    }
    __syncthreads();
#pragma unroll
    for (int dt = 0; dt < 2; ++dt)
#pragma unroll
        for (int r = 0; r < 16; ++r) __hip_atomic_fetch_add(red + r32 * 64 + dt * 32 + crow(r, hi), po[dt][r], __ATOMIC_RELAXED, __HIP_MEMORY_SCOPE_WORKGROUP);
    __syncthreads();
    if (F.tid < 256) { const int c = F.tid >> 3, dc = (F.tid & 7) * 8; const LAS float* s = red + c * 64 + dc;
      u32x4 o; o.x = cvtpk(s[0], s[1]); o.y = cvtpk(s[2], s[3]); o.z = cvtpk(s[4], s[5]); o.w = cvtpk(s[6], s[7]);
      if (c0 + c == 255) o = (u32x4){0u, 0u, 0u, 0u};
      *(u32x4*)((bf16_t*)(a.ws + WS_KC) + ((size_t)(kv * 8 + bg) * 256 + c0 + c) * 64 + dc) = o; }
    __syncthreads();
}

__device__ __forceinline__ void glds16(const void* gsrc, unsigned lds_dst) { unsigned keep;
    asm volatile("s_mov_b32 %0, m0\n\ts_mov_b32 m0, %2\n\ts_nop 0\n\tglobal_load_lds_dwordx4 %1, off\n\ts_mov_b32 m0, %0" : "=&s"(keep) : "v"(gsrc), "s"(lds_dst) : "memory"); }
__device__ __forceinline__ float rowmax32(const f32x16& p0, const f32x16& p1) {
    float a = fmaxf(p0[0], p1[0]);
#pragma unroll
    for (int r = 1; r < 16; ++r) a = fmaxf(a, fmaxf(p0[r], p1[r]));
    auto rr = __builtin_amdgcn_permlane32_swap(__float_as_uint(a), __float_as_uint(a), false, false);
    return fmaxf(__uint_as_float(rr[0]), __uint_as_float(rr[1]));
}
__device__ __forceinline__ float swap_other(float v, int hi) {
    auto rr = __builtin_amdgcn_permlane32_swap(__float_as_uint(v), __float_as_uint(v), false, false);
    return __uint_as_float(hi ? rr[0] : rr[1]);
}
__device__ __forceinline__ unsigned swap_other_u(unsigned v, int hi) {
    auto rr = __builtin_amdgcn_permlane32_swap(v, v, false, false);
    return hi ? rr[0] : rr[1];
}
template <int NK>
__device__ __forceinline__ void qkt(f32x16& p0, f32x16& p1, const LAS unsigned char* Kslot, const bf16x8* qr, float cinit, int r32, int hi) {
    unsigned kbu = (unsigned)(uintptr_t)(Kslot + hi * 1024 + r32 * 16); OPAQUE(kbu); const LAS unsigned char* kb = (const LAS unsigned char*)kbu;
    f32x16 c;
#pragma unroll
    for (int r = 0; r < 16; ++r) c[r] = cinit;
    p0 = c; p1 = c;
#pragma unroll
    for (int d0 = 0; d0 < NK; ++d0) {
        const bf16x8 b0 = *(const LAS bf16x8*)(kb + d0 * 2048);
        const bf16x8 b1 = *(const LAS bf16x8*)(kb + d0 * 2048 + 512);
        p0 = __builtin_amdgcn_mfma_f32_32x32x16_bf16(b0, qr[d0], p0, 0, 0, 0);
        p1 = __builtin_amdgcn_mfma_f32_32x32x16_bf16(b1, qr[d0], p1, 0, 0, 0);
    }
}
__device__ __forceinline__ void pv(f32x16* o, unsigned vb, bf16x8 pa0, bf16x8 pa1, bf16x8 pa2, bf16x8 pa3) {
#pragma unroll
    for (int d0 = 0; d0 < 2; ++d0) { s16x4 lo[4], hi[4];
#pragma unroll
        for (int ks = 0; ks < 4; ++ks) {
            asm volatile("ds_read_b64_tr_b16 %0,%1 offset:%c2" : "=&v"(lo[ks]) : "v"(vb), "i"(d0 * 4096 + ks * 1024) : "memory");
            asm volatile("ds_read_b64_tr_b16 %0,%1 offset:%c2" : "=&v"(hi[ks]) : "v"(vb), "i"(d0 * 4096 + ks * 1024 + 512) : "memory"); }
        asm volatile("s_waitcnt lgkmcnt(0)" ::: "memory"); SBAR();
#define PK(k) (bf16x8){lo[k][0], lo[k][1], lo[k][2], lo[k][3], hi[k][0], hi[k][1], hi[k][2], hi[k][3]}
        o[d0] = __builtin_amdgcn_mfma_f32_32x32x16_bf16(pa0, PK(0), o[d0], 0, 0, 0);
        o[d0] = __builtin_amdgcn_mfma_f32_32x32x16_bf16(pa1, PK(1), o[d0], 0, 0, 0);
        o[d0] = __builtin_amdgcn_mfma_f32_32x32x16_bf16(pa2, PK(2), o[d0], 0, 0, 0);
        o[d0] = __builtin_amdgcn_mfma_f32_32x32x16_bf16(pa3, PK(3), o[d0], 0, 0, 0);
#undef PK
    }
}
__device__ __forceinline__ float softmax_pv(f32x16& p0, f32x16& p1, float& mhat, float& l, f32x16* o, volatile LAS float* wsf, unsigned vb, int r32, int hi) {
    const float rm = rowmax32(p0, p1);
    float f = 1.0f;
    if (__any(rm > 0.f)) {
        const float dl = fmaxf(rm, 0.f); mhat += dl;
#pragma unroll
        for (int r = 0; r < 16; ++r) { p0[r] -= dl; p1[r] -= dl; }
        f = __builtin_amdgcn_exp2f(-dl); l *= f;
        if (hi == 0) wsf[r32] = f;
        LDS_WAIT();
        { unsigned wb = (unsigned)(uintptr_t)(wsf + 4 * hi); OPAQUE(wb); volatile LAS float* wq = (volatile LAS float*)wb;
#pragma unroll
        for (int r = 0; r < 16; ++r) { const float ff = wq[(r & 3) + 8 * (r >> 2)]; o[0][r] *= ff; o[1][r] *= ff; } }
    }
    float s = 0.f;
#pragma unroll
    for (int r = 0; r < 16; ++r) { p0[r] = __builtin_amdgcn_exp2f(p0[r]); p1[r] = __builtin_amdgcn_exp2f(p1[r]); s += p0[r] + p1[r]; }
    l += s;
    u32x4 w0, w1, w2, w3;
    w0 = (u32x4){cvtpk(p0[0], p0[1]), cvtpk(p0[2], p0[3]), cvtpk(p0[4], p0[5]), cvtpk(p0[6], p0[7])};
    w1 = (u32x4){cvtpk(p0[8], p0[9]), cvtpk(p0[10], p0[11]), cvtpk(p0[12], p0[13]), cvtpk(p0[14], p0[15])};
    w2 = (u32x4){cvtpk(p1[0], p1[1]), cvtpk(p1[2], p1[3]), cvtpk(p1[4], p1[5]), cvtpk(p1[6], p1[7])};
    w3 = (u32x4){cvtpk(p1[8], p1[9]), cvtpk(p1[10], p1[11]), cvtpk(p1[12], p1[13]), cvtpk(p1[14], p1[15])};
    pv(o, vb, __builtin_bit_cast(bf16x8, w0), __builtin_bit_cast(bf16x8, w1), __builtin_bit_cast(bf16x8, w2), __builtin_bit_cast(bf16x8, w3));
    return f;
}
__device__ __forceinline__ void lut_bias(f32x16& p0, f32x16& p1, const LAS float* lut, int d0, int hi) {
    const LAS float* lp = lut + (d0 - 4 * hi - 63);
#pragma unroll
    for (int r = 0; r < 16; ++r) { const int ko = (r & 3) + 8 * (r >> 2);
        p0[r] += lp[63 - ko]; p1[r] += lp[63 - ko - 32]; }
}
__device__ __forceinline__ void lut_bias_cmp(f32x16& p0, f32x16& p1, const LAS float* lut, int d0, int hi) {
#pragma unroll
    for (int r = 0; r < 16; ++r) { const int ko = (r & 3) + 8 * (r >> 2) + 4 * hi;
        int n0 = d0 - 16 * ko, n1 = n0 - 512;
        n0 = n0 < -1 ? -1 : (n0 > 128 ? 128 : n0); n1 = n1 < -1 ? -1 : (n1 > 128 ? 128 : n1);
        p0[r] += lut[n0]; p1[r] += lut[n1]; }
}
__device__ __forceinline__ void cmask(f32x16& p0, f32x16& p1, int jb, int qrel, int hi) {
    const int kb = 64 * jb + 4 * hi;
#pragma unroll
    for (int r = 0; r < 16; ++r) { const int kv = kb + (r & 3) + 8 * (r >> 2); if (kv > qrel) p0[r] = NEGBIG; if (kv + 32 > qrel) p1[r] = NEGBIG; }
}
#define WAIT_BAR0() asm volatile("s_waitcnt vmcnt(0) lgkmcnt(0)\n\ts_barrier" ::: "memory")

__device__ __forceinline__ void fox_unit(const Frame& F, const Args& a, int b, int h, int qb) {
    const int lane = F.lane, r32 = lane & 31, hi = lane >> 5, wid = F.wave;
    const unsigned lds0 = (unsigned)(uintptr_t)F.lds;
    const bf16_t* FQ = (const bf16_t*)(a.ws + WS_FQ); const bf16_t* FK = (const bf16_t*)(a.ws + WS_FK); const bf16_t* FV = (const bf16_t*)(a.ws + WS_FV);
    const bf16_t* FB = (const bf16_t*)(a.ws + WS_FB) + (size_t)(b * 8 + h) * T * 16;
    bf16_t* O = (bf16_t*)(a.ws + WS_OFOX);
    const long rowbase = (long)b * T; const int q0 = qb * 256;
    const bf16_t* Kh = FK + rowbase * 512 + h * 64; const bf16_t* Vh = FV + rowbase * 512 + h * 64;
    const bf16_t* ksrc = Kh + (long)lane * 512 + wid * 8;
    const bf16_t* vsrc = Vh + (long)(16 * (wid & 3) + (lane >> 2)) * 512 + (wid >> 2) * 32 + (lane & 3) * 8;
    const bf16_t* fsrc = FB + (long)lane * 16 + (wid & 1) * 8;
    const unsigned kdst = lds0 + L_K + wid * 1024, vdst = lds0 + L_V + wid * 1024, fdst = lds0 + L_K + 8192 + (wid & 1) * 1024;
#define FOX_DMA(t, s) do { glds16(ksrc + (long)(t) * 64 * 512, (unsigned)__builtin_amdgcn_readfirstlane(kdst + (s) * KSLOT)); glds16(vsrc + (long)(t) * 64 * 512, (unsigned)__builtin_amdgcn_readfirstlane(vdst + (s) * VSLOT)); \
        if (wid < 2) glds16(fsrc + (long)(t) * 64 * 16, (unsigned)__builtin_amdgcn_readfirstlane(fdst + (s) * KSLOT)); } while (0)
    const unsigned vb0 = lds0 + L_V + ((lane >> 4) & 1) * 32 + (lane & 3) * 8 + (4 * hi + ((lane & 15) >> 2)) * 64;
    volatile LAS float* wsf = (volatile LAS float*)(F.lds + L_WSF) + wid * 64;
    const int NT = (q0 + 256) / 64;
    __syncthreads();
    FOX_DMA(0, 0);
    bf16x8 qr[5];
    { const bf16_t* Qw = FQ + (rowbase + q0 + wid * 32 + r32) * 512 + h * 64;
#pragma unroll
      for (int d0 = 0; d0 < 4; ++d0) qr[d0] = *(const bf16x8*)(Qw + d0 * 16 + hi * 8);
      const short one = (short)0x3f80; qr[4] = hi ? (bf16x8){0, 0, 0, 0, 0, 0, 0, 0} : (bf16x8){one, one, one, 0, 0, 0, 0, 0}; }
    float mhat = -100.f, l = 0.f; f32x16 o[2]; o[0] = f32x16{}; o[1] = f32x16{};
    const int qrel = wid * 32 + r32;
#pragma unroll 1
    for (int t = 0; t < NT; ++t) {
        WAIT_BAR0();
        if (t + 1 < NT) FOX_DMA(t + 1, (t + 1) & 1);
        f32x16 p0, p1;
        qkt<5>(p0, p1, F.lds + L_K + (t & 1) * KSLOT, qr, -mhat, r32, hi);
        const int jb = t - (NT - 4); if (jb >= 0) cmask(p0, p1, jb, qrel, hi);
        softmax_pv(p0, p1, mhat, l, o, wsf, vb0 + (t & 1) * VSLOT, r32, hi);
    }
    l += swap_other(l, hi);
    if (hi == 0) wsf[32 + r32] = l; LDS_WAIT();
    LAS bf16_t* st = (LAS bf16_t*)(F.lds + L_OST) + wid * 2048;
#pragma unroll
    for (int r = 0; r < 16; ++r) { const int orow = crow(r, hi); const float rl = __builtin_amdgcn_rcpf(wsf[32 + orow]);
#pragma unroll
        for (int d0 = 0; d0 < 2; ++d0) { const unsigned w = cvtpk(o[d0][r] * rl, 0.f); st[orow * 64 + d0 * 32 + r32] = (bf16_t)(w & 0xffffu); } }
    LDS_WAIT();
    bf16_t* Ow = O + (rowbase + q0 + wid * 32) * 512 + h * 64;
#pragma unroll
    for (int i = 0; i < 4; ++i) { const int row = i * 8 + (lane >> 3), ch = lane & 7; const u32x4 v = *(const LAS u32x4*)(st + row * 64 + ch * 8); *(u32x4*)(Ow + (long)row * 512 + ch * 8) = v; }
#undef FOX_DMA
}

__device__ __forceinline__ void nsa_unit(const Frame& F, const Args& a, int bg, int qb) {
    const int wid = F.wave;
    const int b = bg >> 1, g = bg & 1, q0 = qb * 64;
#define NSA_CTX() int lane = F.lane; OPAQUE(lane); const int r32 = lane & 31, hi = lane >> 5; \
    const unsigned lds0 = (unsigned)(uintptr_t)F.lds; \
    const int tok = r32 & 7, hh = r32 >> 3, h = g * 4 + hh, qpos = q0 + 8 * wid + tok; (void)h; (void)qpos; \
    const int koff = lane * 64 + wid * 8, voff = (16 * (wid & 3) + (lane >> 2)) * 64 + (wid >> 2) * 32 + (lane & 3) * 8; (void)koff; (void)voff; \
    const unsigned kdst = lds0 + L_K + wid * 1024, vdst = lds0 + L_V + wid * 1024; (void)kdst; (void)vdst; \
    const unsigned vb0 = lds0 + L_V + ((lane >> 4) & 1) * 32 + (lane & 3) * 8 + (4 * hi + ((lane & 15) >> 2)) * 64; (void)vb0; \
    volatile LAS float* wsf = (volatile LAS float*)(F.lds + L_WSF) + wid * 64; (void)wsf; \
    LAS float* ost = (LAS float*)(F.lds + L_OST) + wid * 2048; (void)ost; \
    const LAS float* lut = (const LAS float*)(F.lds + L_LUT) + hh * 384 + 64; (void)lut
#define NSA_DMA(Kp, Vp, t, s) do { glds16((Kp) + (size_t)(t) * 4096 + koff, (unsigned)__builtin_amdgcn_readfirstlane(kdst + (s) * KSLOT)); glds16((Vp) + (size_t)(t) * 4096 + voff, (unsigned)__builtin_amdgcn_readfirstlane(vdst + (s) * VSLOT)); } while (0)
#define BR_BEGIN() do { mhat = -100.f; l = 0.f; o[0] = f32x16{}; o[1] = f32x16{}; } while (0)
#define BR_END(gate, FIRST) do { l += swap_other(l, hi); const float fac = (l > 0.f) ? (gate) * __builtin_amdgcn_rcpf(l) : 0.f; \
        if (hi == 0) wsf[r32] = fac; LDS_WAIT(); \
        unsigned wb_ = (unsigned)(uintptr_t)(wsf + 4 * hi), ob_ = (unsigned)(uintptr_t)(ost + 4 * hi * 64 + r32); OPAQUE(wb_); OPAQUE(ob_); \
        volatile LAS float* wq_ = (volatile LAS float*)wb_; LAS float* oq_ = (LAS float*)ob_; \
        _Pragma("unroll") for (int r = 0; r < 16; ++r) { const float ff = wq_[(r & 3) + 8 * (r >> 2)]; LAS float* dst = oq_ + ((r & 3) + 8 * (r >> 2)) * 64; \
            if (FIRST) { dst[0] = o[0][r] * ff; dst[32] = o[1][r] * ff; } else { dst[0] += o[0][r] * ff; dst[32] += o[1][r] * ff; } } LDS_WAIT(); } while (0)
    const bf16_t* KV6 = (const bf16_t*)(a.ws + WS_KV6);
    __syncthreads();
    { const float* lg = (const float*)(a.ws + WS_LUT) + (size_t)g * 4 * 384; LAS float* lutl = (LAS float*)(F.lds + L_LUT); for (int i = F.tid; i < 4 * 384; i += 512) lutl[i] = lg[i]; }
    bf16x8 qr[4];
    float gate0, gate1, gate2, b31;
    { NSA_CTX();
      const size_t row = (size_t)b * T + qpos;
      const bf16_t* Qw = (const bf16_t*)(a.ws + WS_NQ) + row * 512 + h * 64;
#pragma unroll
      for (int d0 = 0; d0 < 4; ++d0) qr[d0] = *(const bf16x8*)(Qw + d0 * 16 + hi * 8);
      const float* gl = (const float*)(a.ws + WS_SMALL) + row * 32 + 8 + h * 3;
      gate0 = fsigmoid(gl[0]); gate1 = fsigmoid(gl[1]); gate2 = fsigmoid(gl[2]);
      b31 = ((const float*)(a.ws + WS_LUT))[(size_t)h * 384 + 64 + 128]; }
    float mhat, l; f32x16 o[2];

    unsigned long long selmask;
    {
        NSA_CTX();
        const bf16_t* KCp = (const bf16_t*)(a.ws + WS_KC) + (size_t)bg * 256 * 64; const bf16_t* VCp = KCp + (size_t)8 * 256 * 64;
        const int cmax = (q0 + 63 - 31) >> 4, ncmp = (cmax >> 6) + 1;
        float imp[32];
#pragma unroll
        for (int i = 0; i < 32; ++i) imp[i] = 0.f;
        float carry = 0.f;
        BR_BEGIN();
        __syncthreads();
        NSA_DMA(KCp, VCp, 0, 0);
#pragma unroll
        for (int i = 0; i < 4; ++i) {
            if (i < ncmp) {
                WAIT_BAR0();
                if (i + 1 < ncmp) NSA_DMA(KCp, VCp, i + 1, (i + 1) & 1);
                f32x16 p0, p1;
                qkt<4>(p0, p1, F.lds + L_K + (i & 1) * KSLOT, qr, -mhat, r32, hi);
                lut_bias_cmp(p0, p1, lut, qpos - 31 - 1024 * i, hi);
                const float f = softmax_pv(p0, p1, mhat, l, o, wsf, vb0 + (i & 1) * VSLOT, r32, hi);
#pragma unroll
                for (int k = 0; k < 8 * i; ++k) imp[k] *= f;
                carry *= f;
                float e3[8];
#pragma unroll
                for (int k = 0; k < 8; ++k) { const f32x16& pp = (k < 4) ? p0 : p1; const int rb = 4 * (k & 3);
                    imp[8 * i + k] = (pp[rb] + pp[rb + 1]) + (pp[rb + 2] + pp[rb + 3]); e3[k] = pp[rb + 3]; }
                float pe3[8];
#pragma unroll
                for (int k = 0; k < 8; ++k) pe3[k] = swap_other(e3[k], hi);
#pragma unroll
                for (int k = 0; k < 8; ++k) imp[8 * i + k] += hi ? pe3[k] : (k == 0 ? carry : pe3[k - 1]);
                carry = pe3[7];
            }
        }
        BR_END(gate0, true);
        const float rl = (l > 0.f) ? __builtin_amdgcn_rcpf(l) : 0.f;
        const int cur = qpos >> 6;
        unsigned key[32];
#pragma unroll
        for (int i = 0; i < 32; ++i) { float v = imp[i] * rl; v += __shfl_xor(v, 8); v += __shfl_xor(v, 16);
            const int s = 16 * (i >> 3) + 2 * (i & 7) + hi;
            unsigned kbits = (__float_as_uint(v) & ~63u) | (unsigned)(63 - s);
            if (s == 0 || s == cur || s == cur - 1) kbits = 0x7f000000u | (unsigned)(63 - s);
            if (s > cur) kbits = 0u;
            key[i] = kbits; }
        unsigned long long msk = 0ull;
#pragma unroll 1
        for (int pass = 0; pass < 16; ++pass) {
            unsigned mx = key[0];
#pragma unroll
            for (int i = 1; i < 32; ++i) mx = mx > key[i] ? mx : key[i];
            const unsigned om = swap_other_u(mx, hi); mx = mx > om ? mx : om;
            if (mx != 0u) msk |= 1ull << (63 - (int)(mx & 63u));
#pragma unroll
            for (int i = 0; i < 32; ++i) key[i] = (key[i] == mx) ? 0u : key[i];
        }
        selmask = msk;
    }
#ifndef NO_SEL
    {
        NSA_CTX();
        const bf16_t* KSL = KV6 + 2 * KV6_ELEMS + (size_t)bg * T * 64; const bf16_t* VSL = KV6 + 3 * KV6_ELEMS + (size_t)bg * T * 64;
        BR_BEGIN();
        const int nt = qb + 1;
        __syncthreads();
        NSA_DMA(KSL, VSL, 0, 0);
#pragma unroll 1
        for (int t = 0; t < nt; ++t) {
            WAIT_BAR0();
            if (t + 1 < nt) NSA_DMA(KSL, VSL, t + 1, (t + 1) & 1);
            const bool sel = (selmask >> t) & 1ull;
            const bool band = (t >= qb - 2);
            f32x16 p0, p1;
            qkt<4>(p0, p1, F.lds + L_K + (t & 1) * KSLOT, qr, sel ? (band ? -mhat : b31 - mhat) : NEGBIG, r32, hi);
            if (band) lut_bias(p0, p1, lut, qpos - 64 * t, hi);
            softmax_pv(p0, p1, mhat, l, o, wsf, vb0 + (t & 1) * VSLOT, r32, hi);
        }
        BR_END(gate1, false);
    }
#endif
#ifndef NO_WIN
    {
        NSA_CTX();
        const bf16_t* KWN = KV6 + 4 * KV6_ELEMS + (size_t)bg * T * 64; const bf16_t* VWN = KV6 + 5 * KV6_ELEMS + (size_t)bg * T * 64;
        const LAS float* lutw = lut - 64 + 256 - 448;
        BR_BEGIN();
        const int t0 = qb >= 8 ? qb - 8 : 0, nt = qb - t0 + 1;
        __syncthreads();
        NSA_DMA(KWN, VWN, t0, 0);
#pragma unroll 1
        for (int i = 0; i < nt; ++i) {
            const int t = t0 + i;
            WAIT_BAR0();
            if (i + 1 < nt) NSA_DMA(KWN, VWN, t + 1, (i + 1) & 1);
            const bool band = (t >= qb - 2), far = (t == qb - 8);
            f32x16 p0, p1;
            qkt<4>(p0, p1, F.lds + L_K + (i & 1) * KSLOT, qr, (band || far) ? -mhat : b31 - mhat, r32, hi);
            if (band) lut_bias(p0, p1, lut, qpos - 64 * t, hi);
            else if (far) lut_bias(p0, p1, lutw, qpos - 64 * t, hi);
            softmax_pv(p0, p1, mhat, l, o, wsf, vb0 + (i & 1) * VSLOT, r32, hi);
        }
        BR_END(gate2, false);
    }
#endif
    {
        NSA_CTX();
        bf16_t* O = (bf16_t*)(a.ws + WS_ONSA);
#pragma unroll
        for (int i = 0; i < 4; ++i) { const int rr = i * 8 + (lane >> 3), ch = lane & 7; const LAS f32x4* sp = (const LAS f32x4*)(ost + rr * 64 + ch * 8); const f32x4 v0 = sp[0], v1 = sp[1];
            const int tk = rr & 7, h2 = g * 4 + (rr >> 3);
            *(u32x4*)(O + ((size_t)b * T + q0 + 8 * wid + tk) * 512 + h2 * 64 + ch * 8) = pg8::pack8(v0, v1); }
    }
#undef NSA_CTX
#undef NSA_DMA
#undef BR_BEGIN
#undef BR_END
}

__global__ void __launch_bounds__(NWAVES * 64, 2) fwd_kernel(Args a) {
    extern __shared__ __attribute__((aligned(16))) unsigned char lds_raw[];
    Frame F; F.lds = (LAS unsigned char*)lds_raw; F.tid = threadIdx.x; F.lane = F.tid & 63; F.wave = __builtin_amdgcn_readfirstlane(F.tid >> 6); F.G = gridDim.x; F.bid = blockIdx.x;
    unsigned char* ws = a.ws;
    const int lo = a.ph_lo, hi = a.ph_hi;
#ifndef PH_MASK
#define PH_MASK 0x1ff
#endif
#define IN(k) (((PH_MASK >> (k)) & 1) && lo <= (k) && (k) < hi)
    volatile LAS unsigned* MISC = (volatile LAS unsigned*)(F.lds + L_MISC);
    if (F.tid < 16) MISC[F.tid] = 0u;
    __syncthreads();
    const XcdBarrier xbar = xcd_barrier_post((unsigned*)(ws + WS_BAR) + a.li * XCD_BAR_WORDS, MISC);
#define SEAM(k) do { if (IN(k) && IN((k) + 1)) xcd_barrier(xbar); } while (0)
    if (IN(0)) { p0_prologue(F, a); } SEAM(0);
    if (IN(1)) {
        pg8::Gemm g{(const bf16_t*)(ws + WS_XN), nullptr, (const bf16_t*)(ws + WS_WIN), nullptr, M, NIN, D};
        pg8::StaticOrder S; S.init(M, NIN, F.G, F.bid, 0);
        pg8::EpiQKV E{(bf16_t*)(ws + WS_FQ), (bf16_t*)(ws + WS_FK), (bf16_t*)(ws + WS_FV), (bf16_t*)(ws + WS_NQ), (bf16_t*)(ws + WS_KV6), (bf16_t*)(ws + WS_GA), (bf16_t*)(ws + WS_GB), (float*)(ws + WS_SMALL)};
        pg8::gemm_phase<pg8::EpiQKV, true, true>(F.lds, g, S, E);
    } SEAM(1);
    if (IN(2)) {
        for (int u = F.bid; u < 128; u += F.G) compress_unit(F, a, u);
        for (int s = 0; s < 32; ++s) if (((s + 128) % F.G) == F.bid) scan_seq(F, a, s);
    } SEAM(2);
    if (IN(3)) {
        for (int v = F.bid; v < 256; v += F.G) {
#ifndef NO_FOX
            { const int bh = v >> 3, s = v & 7; for (int k = 0; k < 2; ++k) fox_unit(F, a, bh >> 3, bh & 7, k ? 15 - s : s); }
#endif
#ifndef NO_NSA
            { const int bg = v >> 5, s = v & 31; for (int k = 0; k < 2; ++k) nsa_unit(F, a, bg, k ? 63 - s : s); }
#endif
        }
        __syncthreads();
    } SEAM(3);
    if (IN(4)) {
        pg8::Gemm g{(const bf16_t*)(ws + WS_OFOX), (const bf16_t*)(ws + WS_ONSA), (const bf16_t*)(ws + WS_WF), (const bf16_t*)(ws + WS_WN), M, D, 512};
        pg8::StaticOrder S; S.init(M, D, F.G, F.bid, 1);
        pg8::EpiMerge E{(const bf16_t*)(ws + WS_GA), (const bf16_t*)(ws + WS_GB), (bf16_t*)(ws + WS_MERGED)};
        pg8::gemm_phase<pg8::EpiMerge, true, true>(F.lds, g, S, E);
    } SEAM(4);
    if (IN(5)) {
        pg8::Gemm g{(const bf16_t*)(ws + WS_MERGED), nullptr, (const bf16_t*)(ws + WS_WOUT), nullptr, M, D, D};
        pg8::StaticOrder S; S.init(M, D, F.G, F.bid, 0);
        pg8::EpiRes E{a.x, a.out, (bf16_t*)(ws + WS_XN), (float*)(ws + WS_SSQ1)};
        pg8::gemm_phase<pg8::EpiRes, true, true>(F.lds, g, S, E);
    } SEAM(5);
    if (IN(6)) {
        pg8::Gemm g{(const bf16_t*)(ws + WS_XN), nullptr, (const bf16_t*)(ws + WS_W1), nullptr, M, FF, D};
        pg8::StaticOrder S; S.init(M, FF, F.G, F.bid, 0);
        pg8::EpiFF1 E{(const float*)(ws + WS_SSQ1), (bf16_t*)(ws + WS_H)};
        pg8::gemm_phase<pg8::EpiFF1, true, true>(F.lds, g, S, E);
    } SEAM(6);
    if (IN(7)) {
        pg8::Gemm g{(const bf16_t*)(ws + WS_H), nullptr, (const bf16_t*)(ws + WS_W2), nullptr, M, D, FF};
        pg8::StaticOrder S; S.init(M, D, F.G, F.bid, 0);
        pg8::EpiRes E{a.out, a.out, nullptr, (float*)(ws + WS_SSQ2)};
        pg8::gemm_phase<pg8::EpiRes, true, true>(F.lds, g, S, E);
    } SEAM(7);
    if (IN(8)) {
        const int gw = F.bid * NWAVES + F.wave, NGW = F.G * NWAVES;
        const f32x4* gp = (const f32x4*)a.g_final + F.lane; f32x4 gv[4];
#pragma unroll
        for (int j = 0; j < 4; ++j) gv[j] = gp[64 * j];
        for (int m = gw; m < M; m += NGW) {
            const f32x4* sp = (const f32x4*)((const float*)(ws + WS_SSQ2) + (size_t)m * 16); const f32x4 s = (sp[0] + sp[1]) + (sp[2] + sp[3]);
            const float rstd = 1.0f / sqrtf(((s[0] + s[1]) + (s[2] + s[3])) * (1.0f / D) + RMS_EPS);
            f32x4* xr = (f32x4*)(a.out + (size_t)m * D) + F.lane;
#pragma unroll
            for (int j = 0; j < 4; ++j) xr[64 * j] = xr[64 * j] * rstd * gv[j];
        }
    }
#undef IN
#undef SEAM
}

extern "C" void kernel_launch(void* const* d_in, const int* in_sizes, int n_in, void* d_out, int out_size, void* d_ws, size_t ws_size, hipStream_t stream) {
    static int grid = 0;
    if (grid == 0) {
        if (n_in != 18 || in_sizes[0] != M * D || out_size != M * D || ws_size < WS_END) { fprintf(stderr, "kernel_launch: unexpected shapes (n_in %d, in0 %d, out %d, ws %zu)\n", n_in, n_in > 0 ? in_sizes[0] : -1, out_size, ws_size); grid = -1; return; }
        int dev = 0, cus = 0, per_cu = 0;
        if (hipGetDevice(&dev) != hipSuccess || hipDeviceGetAttribute(&cus, hipDeviceAttributeMultiprocessorCount, dev) != hipSuccess) { grid = -1; return; }
        if (hipFuncSetAttribute((const void*)fwd_kernel, hipFuncAttributeMaxDynamicSharedMemorySize, LDS_BYTES) != hipSuccess) { fprintf(stderr, "hipFuncSetAttribute failed\n"); grid = -1; return; }
        if (hipOccupancyMaxActiveBlocksPerMultiprocessor(&per_cu, (const void*)fwd_kernel, NWAVES * 64, LDS_BYTES) != hipSuccess || per_cu < 1) { fprintf(stderr, "occupancy query: %d blocks/CU\n", per_cu); grid = -1; (void)hipGetLastError(); return; }
        grid = cus;
    }
    if (grid < 0) return;
    (void)hipMemsetAsync((char*)d_ws + WS_CTL, 0, CTL_ZERO_BYTES, stream);
    Args a{};
    const float** p = (const float**)&a;
    for (int i = 0; i < 18; ++i) p[i] = (const float*)d_in[i];
    a.out = (float*)d_out; a.ws = (unsigned char*)d_ws;
    constexpr int NPH = 9;
#ifdef PROBE_PH
    const int cuts[3] = {0, PROBE_PH + 1, NPH}; const int los[2] = {0, PROBE_PH}; const int nl = 2;
#elif defined(PROBE_SPLIT)
    const int cuts[3] = {0, PROBE_SPLIT, NPH}; const int los[2] = {0, PROBE_SPLIT}; const int nl = 2;
#else
    const int cuts[3] = {0, NPH, NPH}; const int los[2] = {0, 0}; const int nl = 1;
#endif
    for (int li = 0; li < nl; ++li) {
        a.ph_lo = los[li]; a.ph_hi = cuts[li + 1]; a.li = li;
        void* args[] = {&a};
        hipError_t e = hipLaunchCooperativeKernel((void*)fwd_kernel, dim3(grid), dim3(NWAVES * 64), args, LDS_BYTES, stream);
        if (e != hipSuccess) { fprintf(stderr, "cooperative launch failed: %s (grid %d)\n", hipGetErrorString(e), grid); break; }
    }
}
```

```cpp
#include <hip/hip_runtime.h>
#include <hip/hip_cooperative_groups.h>
#include <hip/hip_bf16.h>
#include <cstdio>
#include <cstdint>
#include <cmath>
namespace cg = cooperative_groups;

#define LAS __attribute__((address_space(3)))
#define GAS __attribute__((address_space(1)))
typedef unsigned short bf16_t;
typedef short bf16x8 __attribute__((ext_vector_type(8)));
typedef short s16x4 __attribute__((ext_vector_type(4)));
typedef float f32x4 __attribute__((ext_vector_type(4)));
typedef float f32x2 __attribute__((ext_vector_type(2)));
typedef float f32x16 __attribute__((ext_vector_type(16)));
typedef unsigned u32x4 __attribute__((ext_vector_type(4)));
typedef unsigned u32x2 __attribute__((ext_vector_type(2)));
typedef __bf16 bf16x2_t __attribute__((ext_vector_type(2)));

constexpr int BATCH = 4, T = 4096, D = 1024, M = BATCH * T, FF = 4096;
constexpr int NIN = 5120;
constexpr int NKV = 2, NH = 8, HD = 64;
constexpr float RMS_EPS = 1e-6f;
constexpr float LOG2E = 1.4426950408889634f;
constexpr float C2 = 0.125f * LOG2E;
constexpr float NEGBIG = -1.0e30f;
constexpr int NWAVES = 8;

constexpr size_t MiB = 1u << 20;
constexpr size_t WS_CTL = 0, CTL_ZERO_BYTES = 64 * 1024;
constexpr size_t WS_BAR = 16384;
constexpr size_t WS_CB1 = 1 * MiB + 128 * 1024;
constexpr size_t WS_LUT = 1 * MiB;
constexpr size_t WS_CW2T = 1 * MiB + 64 * 1024;
constexpr size_t WS_SSQ1 = 2 * MiB, WS_SSQ2 = 3 * MiB;
constexpr size_t WS_WIN = 4 * MiB;
constexpr size_t WS_WF = 14 * MiB, WS_WN = 15 * MiB;
constexpr size_t WS_WOUT = 16 * MiB;
constexpr size_t WS_W1 = 18 * MiB, WS_W2 = 26 * MiB;
constexpr size_t WS_CW1 = 34 * MiB;
constexpr size_t WS_KC = 36 * MiB;
constexpr size_t WS_FB = 37 * MiB;
constexpr size_t WS_SMALL = 41 * MiB;
constexpr size_t WS_XN = 44 * MiB;
constexpr size_t WS_OFOX = 44 * MiB, WS_ONSA = 60 * MiB;
constexpr size_t WS_FQ = 76 * MiB, WS_FK = 92 * MiB, WS_FV = 108 * MiB, WS_NQ = 124 * MiB;
constexpr size_t WS_KV6 = 140 * MiB;
constexpr size_t KV6_ELEMS = (size_t)BATCH * NKV * T * HD;
constexpr size_t WS_GA = 165 * MiB, WS_GB = 197 * MiB;
constexpr size_t WS_MERGED = 76 * MiB;
constexpr size_t WS_H = 76 * MiB;
constexpr size_t WS_END = 229 * MiB;

constexpr int LDS_BYTES = 147456;
constexpr int KSLOT = 10240, VSLOT = 8192;
constexpr int L_K = 0, L_V = 3 * KSLOT, L_WSF = L_V + 2 * VSLOT, L_OST = L_WSF + 2048, L_LUT = L_OST + 8 * 8192, L_ATT_END = L_LUT + 4 * 384 * 4;
static_assert(L_ATT_END <= 131072, "attention LDS");
constexpr int L_MISC = 131072;

__device__ __forceinline__ unsigned cvtpk(float lo, float hi) { f32x2 v = {lo, hi}; bf16x2_t b = __builtin_convertvector(v, bf16x2_t); return __builtin_bit_cast(unsigned, b); }
__device__ __forceinline__ float bf_lo(unsigned w) { return __uint_as_float(w << 16); }
__device__ __forceinline__ float bf_hi(unsigned w) { return __uint_as_float(w & 0xffff0000u); }
__device__ __forceinline__ float fsigmoid(float x) { return __builtin_amdgcn_rcpf(1.0f + __builtin_amdgcn_exp2f(-x * LOG2E)); }
__device__ __forceinline__ int crow(int r, int hi) { return (r & 3) + 8 * (r >> 2) + 4 * hi; }
#define SBAR() __builtin_amdgcn_sched_barrier(0)
#define OPAQUE(x) asm volatile("" : "+v"(x))
#define LDS_WAIT() asm volatile("s_waitcnt lgkmcnt(0)" ::: "memory")
#define VM_WAIT() asm volatile("s_waitcnt vmcnt(0)" ::: "memory")

namespace pg8 {
constexpr int BM = 256, BK = 64, HALF = 128, HTB = HALF * BK * 2, STAGE_BYTES = 8 * HTB, NXCD = 8, WGM = 8;
__host__ __device__ __forceinline__ int lds_byte(int r, int c) { const int st = (r >> 4) * 2 + (c >> 5), rr = r & 15, cc = c & 31, ob = rr * 64 + cc * 2; return st * 1024 + (ob ^ (((ob >> 9) & 1) << 5)); }
__host__ __device__ __forceinline__ void stage_rc(int b, int& R, int& C) { const int st = b / 1024, sb = b % 1024, swz = sb ^ (((sb >> 9) & 1) << 5); R = (st >> 1) * 16 + swz / 64; C = (st & 1) * 32 + (swz % 64) / 2; }
__host__ __device__ __forceinline__ int perm32(int rho) { const int n = rho >> 4, i = rho & 15; return 8 * (i >> 2) + 4 * n + (i & 3); }

struct Unit { int pm, pn, w; };
struct Gemm { const bf16_t* A0; const bf16_t* A1; const bf16_t* B0; const bf16_t* B1; int M, N, K; };

struct StaticOrder {
    int nM, nN, nwg, G, c, dual;
    __device__ void init(int M_, int N_, int G_, int c_, int dual_) { nM = M_ / BM; nN = N_ / BM; nwg = nM * nN; G = G_; c = c_; dual = dual_; }
    __device__ bool next(int i, Unit& u) const {
        const int ti = dual ? (i >> 1) : i; u.w = dual ? (i & 1) : 0;
        const long L = (long)ti * G + c; if (L >= nwg) return false;
        int wgid = (int)L; { const int q = nwg / NXCD, r = nwg % NXCD, xcd = wgid % NXCD, off = wgid / NXCD; wgid = (xcd < r ? xcd * (q + 1) : r * (q + 1) + (xcd - r) * q) + off; }
        const int nig = WGM * nN, gid = wgid / nig, fm = gid * WGM, gsz = (nM - fm) < WGM ? (nM - fm) : WGM;
        u.pm = fm + ((wgid % nig) % gsz); u.pn = (wgid % nig) / gsz; return true;
    }
};

typedef f32x4 Acc[2][2][4][2];

template <class Epi, bool ALIGN_EPI, bool SP2>
__device__ __forceinline__ void gemm_phase(LAS unsigned char* lds, const Gemm g, const StaticOrder& S, const Epi& E) {
    const int tid = threadIdx.x, wid = __builtin_amdgcn_readfirstlane(tid >> 6), lane = tid & 63, wr = wid >> 2, wc = wid & 3, fr = lane & 15, fq = lane >> 4;
    const int K = g.K, nt = K / BK;
    unsigned voffA[2], voffB[2];
#pragma unroll
    for (int i = 0; i < 2; ++i) { int R, C; stage_rc(tid * 16 + i * 8192, R, C); const int Rb = Epi::PERM ? ((R & ~31) + perm32(R & 31)) : R;
        voffA[i] = (unsigned)(R * K + C) * 2u; voffB[i] = (unsigned)(Rb * K + C) * 2u; }
    const size_t kstep = (size_t)(BK * 2);
    const size_t hstep = (size_t)HALF * K * 2;
    const size_t tstep = 2 * hstep;
    const unsigned ldsw = (unsigned)wid * 1024u;
    const int aoff = lds_byte(wr * 64 + fr, fq * 8), boff = lds_byte(wc * 32 + fr, fq * 8);
#define PG8_SA(b, h) (((b) * 2 + (h)) * HTB)
#define PG8_SB(b, h) ((4 + (b) * 2 + (h)) * HTB)
#define PG8_STAGE(bufoff, gbase, voff) do { _Pragma("unroll") for (int _i = 0; _i < 2; ++_i) \
        __builtin_amdgcn_global_load_lds((const unsigned*)((const char*)(gbase) + (voff)[_i]), (LAS unsigned*)(lds + (bufoff) + ldsw + _i * 8192), 16, 0, 0); } while (0)
#define PG8_LDA(dst, b, h) do { _Pragma("unroll") for (int m = 0; m < 4; ++m) _Pragma("unroll") for (int k = 0; k < 2; ++k) dst[m][k] = *(const LAS bf16x8*)(lds + PG8_SA(b, h) + aoff + m * 2048 + k * 1024); } while (0)
#define PG8_LDB(dst, b, h) do { _Pragma("unroll") for (int n = 0; n < 2; ++n) _Pragma("unroll") for (int k = 0; k < 2; ++k) dst[n][k] = *(const LAS bf16x8*)(lds + PG8_SB(b, h) + boff + n * 2048 + k * 1024); } while (0)
#define PG8_MMA(ai, bj, At, Bt) do { __builtin_amdgcn_s_setprio(1); _Pragma("unroll") for (int m = 0; m < 4; ++m) _Pragma("unroll") for (int n = 0; n < 2; ++n) _Pragma("unroll") for (int k = 0; k < 2; ++k) \
        acc[ai][bj][m][n] = __builtin_amdgcn_mfma_f32_16x16x32_bf16(Bt[n][k], At[m][k], acc[ai][bj][m][n], 0, 0, 0); __builtin_amdgcn_s_setprio(0); } while (0)
#define PG8_WAIT_V(n) asm volatile("s_waitcnt vmcnt(" #n ")" ::: "memory")
#define PG8_WAIT_L(n) asm volatile("s_waitcnt lgkmcnt(" #n ")" ::: "memory")
#define PG8_BAR __builtin_amdgcn_s_barrier()
#define PG8_SCHED __builtin_amdgcn_sched_barrier(0)
    Unit cur, nxt; int ui = 0;
    if (!S.next(0, cur)) return;
    Acc acc;
#pragma unroll
    for (int a = 0; a < 2; ++a)
#pragma unroll
        for (int b = 0; b < 2; ++b)
#pragma unroll
            for (int m = 0; m < 4; ++m)
#pragma unroll
                for (int n = 0; n < 2; ++n) acc[a][b][m][n] = (f32x4){0.f, 0.f, 0.f, 0.f};
    bf16x8 At[4][2], B0[2][2], B1[2][2];
    const char* cA = (const char*)(cur.w ? g.A1 : g.A0) + (size_t)cur.pm * tstep; const char* cB = (const char*)(cur.w ? g.B1 : g.B0) + (size_t)cur.pn * tstep;
    if constexpr (SP2) {
        PG8_STAGE(PG8_SB(0, 0), cB, voffB); PG8_STAGE(PG8_SB(0, 1), cB + hstep, voffB); PG8_STAGE(PG8_SA(0, 0), cA, voffA); PG8_STAGE(PG8_SA(0, 1), cA + hstep, voffA);
        if (wr == 1) PG8_BAR;
        PG8_WAIT_V(2); PG8_BAR;
        PG8_STAGE(PG8_SB(1, 0), cB + kstep, voffB); PG8_STAGE(PG8_SA(1, 0), cA + kstep, voffA); PG8_STAGE(PG8_SB(1, 1), cB + hstep + kstep, voffB);
        PG8_WAIT_V(6); PG8_BAR;
    } else {
        PG8_STAGE(PG8_SB(0, 0), cB, voffB); PG8_STAGE(PG8_SA(0, 0), cA, voffA); PG8_STAGE(PG8_SB(0, 1), cB + hstep, voffB); PG8_STAGE(PG8_SA(0, 1), cA + hstep, voffA);
        if (wr == 1) PG8_BAR;
        PG8_WAIT_V(4); PG8_BAR;
        PG8_STAGE(PG8_SB(1, 0), cB + kstep, voffB); PG8_STAGE(PG8_SA(1, 0), cA + kstep, voffA); PG8_STAGE(PG8_SB(1, 1), cB + hstep + kstep, voffB);
        PG8_WAIT_V(6); PG8_BAR;
    }
    for (;;) {
        const bool has_next = S.next(ui + 1, nxt);
        const char* nA = has_next ? (const char*)(nxt.w ? g.A1 : g.A0) + (size_t)nxt.pm * tstep : cA; const char* nB = has_next ? (const char*)(nxt.w ? g.B1 : g.B0) + (size_t)nxt.pn * tstep : cB;
        for (int t = 0; t < nt; t += 2) {
            const bool last = (t == nt - 2);
            const char* a1 = cA + (size_t)(t + 1) * kstep;
            const char* a2 = last ? nA : cA + (size_t)(t + 2) * kstep; const char* b2 = last ? nB : cB + (size_t)(t + 2) * kstep;
            const char* a3 = a2 + kstep; const char* b3 = b2 + kstep;
            if constexpr (SP2) {
            PG8_LDB(B0, 0, 0); PG8_LDB(B1, 0, 1); PG8_SCHED; PG8_LDA(At, 0, 0); PG8_STAGE(PG8_SA(1, 1), a1 + hstep, voffA);
            PG8_WAIT_V(8); PG8_WAIT_L(0); PG8_BAR; PG8_MMA(0, 0, At, B0); PG8_MMA(0, 1, At, B1); PG8_BAR; PG8_SCHED;
            PG8_LDA(At, 0, 1); PG8_STAGE(PG8_SB(0, 0), b2, voffB); PG8_STAGE(PG8_SB(0, 1), b2 + hstep, voffB); PG8_STAGE(PG8_SA(0, 0), a2, voffA);
            PG8_WAIT_V(8); PG8_WAIT_L(0); PG8_BAR; PG8_MMA(1, 0, At, B0); PG8_MMA(1, 1, At, B1); PG8_BAR; PG8_SCHED;
            PG8_LDB(B0, 1, 0); PG8_LDB(B1, 1, 1); PG8_SCHED; PG8_LDA(At, 1, 0); PG8_STAGE(PG8_SA(0, 1), a2 + hstep, voffA);
            PG8_WAIT_V(8); PG8_WAIT_L(0); PG8_BAR; PG8_MMA(0, 0, At, B0); PG8_MMA(0, 1, At, B1); PG8_BAR; PG8_SCHED;
            PG8_LDA(At, 1, 1); PG8_STAGE(PG8_SB(1, 0), b3, voffB); PG8_STAGE(PG8_SB(1, 1), b3 + hstep, voffB); PG8_STAGE(PG8_SA(1, 0), a3, voffA);
            PG8_WAIT_V(8); PG8_WAIT_L(0); PG8_BAR; PG8_MMA(1, 0, At, B0); PG8_MMA(1, 1, At, B1); PG8_BAR; PG8_SCHED;
            } else {
            PG8_LDB(B0, 0, 0); PG8_SCHED; PG8_LDA(At, 0, 0); PG8_STAGE(PG8_SA(1, 1), a1 + hstep, voffA);
            PG8_WAIT_L(8); PG8_BAR; PG8_WAIT_L(0); PG8_MMA(0, 0, At, B0); PG8_BAR; PG8_SCHED;
            PG8_LDB(B1, 0, 1); PG8_STAGE(PG8_SB(0, 0), b2, voffB);
            PG8_BAR; PG8_WAIT_L(0); PG8_MMA(0, 1, At, B1); PG8_BAR;
            PG8_LDA(At, 0, 1); PG8_STAGE(PG8_SA(0, 0), a2, voffA);
            PG8_BAR; PG8_WAIT_L(0); PG8_MMA(1, 0, At, B0); PG8_BAR; PG8_SCHED;
            PG8_STAGE(PG8_SB(0, 1), b2 + hstep, voffB);
            PG8_WAIT_V(6); PG8_BAR; PG8_MMA(1, 1, At, B1); PG8_BAR;
            PG8_LDB(B0, 1, 0); PG8_SCHED; PG8_LDA(At, 1, 0); PG8_STAGE(PG8_SA(0, 1), a2 + hstep, voffA);
            PG8_WAIT_L(8); PG8_BAR; PG8_WAIT_L(0); PG8_MMA(0, 0, At, B0); PG8_BAR; PG8_SCHED;
            PG8_LDB(B1, 1, 1); PG8_STAGE(PG8_SB(1, 0), b3, voffB);
            PG8_BAR; PG8_WAIT_L(0); PG8_MMA(0, 1, At, B1); PG8_BAR;
            PG8_LDA(At, 1, 1); PG8_STAGE(PG8_SA(1, 0), a3, voffA);
            PG8_BAR; PG8_WAIT_L(0); PG8_MMA(1, 0, At, B0); PG8_BAR; PG8_SCHED;
            PG8_STAGE(PG8_SB(1, 1), b3 + hstep, voffB);
            PG8_WAIT_V(6); PG8_BAR; PG8_MMA(1, 1, At, B1); PG8_BAR;
            }
        }
        if constexpr (ALIGN_EPI) { if (wr == 0) PG8_BAR; }
        const bool keep = Epi::DUAL && (cur.w == 0);
        if (keep) E.mid(acc, cur, wr, wc, fr, fq); else E(acc, cur, wr, wc, fr, fq);
        if (!has_next) break;
        if (!keep) {
#pragma unroll
        for (int a = 0; a < 2; ++a)
#pragma unroll
            for (int b = 0; b < 2; ++b)
#pragma unroll
                for (int m = 0; m < 4; ++m)
#pragma unroll
                    for (int n = 0; n < 2; ++n) acc[a][b][m][n] = (f32x4){0.f, 0.f, 0.f, 0.f};
        }
        cur = nxt; cA = nA; cB = nB; ++ui;
        if constexpr (ALIGN_EPI) { if (wr == 1) PG8_BAR; }
    }
    PG8_WAIT_V(0);
    if constexpr (!ALIGN_EPI) { if (wr == 0) PG8_BAR; }
    PG8_BAR;
#undef PG8_SA
#undef PG8_SB
#undef PG8_STAGE
#undef PG8_LDA
#undef PG8_LDB
#undef PG8_MMA
#undef PG8_WAIT_V
#undef PG8_WAIT_L
#undef PG8_BAR
#undef PG8_SCHED
}

__device__ __forceinline__ u32x4 pack8(f32x4 v0, f32x4 v1) { u32x4 w; w.x = cvtpk(v0[0], v0[1]); w.y = cvtpk(v0[2], v0[3]); w.z = cvtpk(v1[0], v1[1]); w.w = cvtpk(v1[2], v1[3]); return w; }

struct EpiQKV {
    static constexpr bool PERM = true, DUAL = false;
    bf16_t *FQ, *FK, *FV, *NQ, *KV6, *GA, *GB; float* SMALL;
    __device__ __forceinline__ void mid(Acc& acc, const Unit& u, int wr, int wc, int fr, int fq) const {}
    __device__ __forceinline__ void operator()(const Acc& acc, const Unit& u, int wr, int wc, int fr, int fq) const {
        const int pn = u.pn, row0 = u.pm * BM + wr * 64 + fr, cl = wc * 32 + 8 * fq;
#pragma unroll
        for (int ai = 0; ai < 2; ++ai)
#pragma unroll
            for (int m = 0; m < 4; ++m) { const int row = row0 + ai * HALF + m * 16;
#pragma unroll
                for (int bj = 0; bj < 2; ++bj) { f32x4 v0 = acc[ai][bj][m][0], v1 = acc[ai][bj][m][1]; const int c = bj * HALF + cl;
                    if (pn < 8) { bf16_t* base = FQ + (size_t)(pn >> 1) * (8u << 20); const float sc = (pn < 2 || pn >= 6) ? C2 : 1.f;
                        *(u32x4*)(base + (size_t)row * 512 + (pn & 1) * 256 + c) = pack8(v0 * sc, v1 * sc);
                    } else if (pn < 11) { const int n6 = (pn - 8) * 256 + c, which = n6 >> 7, gg = (n6 >> 6) & 1, d = n6 & 63, b = row >> 12, t = row & 4095;
                        *(u32x4*)(KV6 + (size_t)which * KV6_ELEMS + ((size_t)((b * 2 + gg) * T + t) * 64 + d)) = pack8(v0, v1);
                    } else if (pn < 19) { bf16_t* base = GA + (size_t)((pn - 11) >> 2) * (16u << 20); const int col = ((pn - 11) & 3) * 256 + c;
                        f32x4 s0, s1;
#pragma unroll
                        for (int e = 0; e < 4; ++e) { s0[e] = fsigmoid(v0[e]); s1[e] = fsigmoid(v1[e]); }
                        *(u32x4*)(base + (size_t)row * 1024 + col) = pack8(s0, s1);
                    } else { if (c < 32) { *(f32x4*)(SMALL + (size_t)row * 32 + c) = v0; *(f32x4*)(SMALL + (size_t)row * 32 + c + 4) = v1; } }
                } }
    }
};
struct EpiMerge {
    static constexpr bool PERM = true, DUAL = true;
    const bf16_t *GA, *GB; bf16_t* OUT;
    __device__ __forceinline__ void mid(Acc& acc, const Unit& u, int wr, int wc, int fr, int fq) const {
        const int row0 = u.pm * BM + wr * 64 + fr, col0 = u.pn * BM + wc * 32 + 8 * fq;
#pragma unroll
        for (int ai = 0; ai < 2; ++ai)
#pragma unroll
            for (int m = 0; m < 4; ++m) { const size_t ro = (size_t)(row0 + ai * HALF + m * 16) * 1024 + col0;
#pragma unroll
                for (int bj = 0; bj < 2; ++bj) { const u32x4 a = *(const u32x4*)(GA + ro + bj * HALF), b = *(const u32x4*)(GB + ro + bj * HALF);
                    f32x4 r0, r1;
                    r0[0] = bf_lo(a.x) * __builtin_amdgcn_rcpf(bf_lo(b.x)); r0[1] = bf_hi(a.x) * __builtin_amdgcn_rcpf(bf_hi(b.x));
                    r0[2] = bf_lo(a.y) * __builtin_amdgcn_rcpf(bf_lo(b.y)); r0[3] = bf_hi(a.y) * __builtin_amdgcn_rcpf(bf_hi(b.y));
                    r1[0] = bf_lo(a.z) * __builtin_amdgcn_rcpf(bf_lo(b.z)); r1[1] = bf_hi(a.z) * __builtin_amdgcn_rcpf(bf_hi(b.z));
                    r1[2] = bf_lo(a.w) * __builtin_amdgcn_rcpf(bf_lo(b.w)); r1[3] = bf_hi(a.w) * __builtin_amdgcn_rcpf(bf_hi(b.w));
                    acc[ai][bj][m][0] *= r0; acc[ai][bj][m][1] *= r1; } }
    }
    __device__ __forceinline__ void operator()(const Acc& acc, const Unit& u, int wr, int wc, int fr, int fq) const {
        const int row0 = u.pm * BM + wr * 64 + fr, col0 = u.pn * BM + wc * 32 + 8 * fq;
#pragma unroll
        for (int ai = 0; ai < 2; ++ai)
#pragma unroll
            for (int m = 0; m < 4; ++m) { const size_t ro = (size_t)(row0 + ai * HALF + m * 16) * 1024 + col0;
#pragma unroll
                for (int bj = 0; bj < 2; ++bj) { const u32x4 b = *(const u32x4*)(GB + ro + bj * HALF);
                    const f32x4 g0 = {bf_lo(b.x), bf_hi(b.x), bf_lo(b.y), bf_hi(b.y)}, g1 = {bf_lo(b.z), bf_hi(b.z), bf_lo(b.w), bf_hi(b.w)};
                    *(u32x4*)(OUT + ro + bj * HALF) = pack8(acc[ai][bj][m][0] * g0, acc[ai][bj][m][1] * g1); } }
    }
};
struct EpiRes {
    static constexpr bool PERM = false, DUAL = false;
    const float* base; float* out; bf16_t* xb; float* ssqp;
    __device__ __forceinline__ void mid(Acc& acc, const Unit& u, int wr, int wc, int fr, int fq) const {}
    __device__ __forceinline__ void operator()(const Acc& acc, const Unit& u, int wr, int wc, int fr, int fq) const {
        const int row0 = u.pm * BM + wr * 64 + fr, col0 = u.pn * BM + wc * 32 + 4 * fq;
#pragma unroll
        for (int ai = 0; ai < 2; ++ai)
#pragma unroll
            for (int m = 0; m < 4; ++m) { const int row = row0 + ai * HALF + m * 16; const size_t ro = (size_t)row * 1024 + col0; float ss = 0.f;
#pragma unroll
                for (int bj = 0; bj < 2; ++bj)
#pragma unroll
                    for (int n = 0; n < 2; ++n) { const size_t o = ro + bj * HALF + n * 16; const f32x4 v = *(const f32x4*)(base + o) + acc[ai][bj][m][n];
                        *(f32x4*)(out + o) = v; ss += (v[0] * v[0] + v[1] * v[1]) + (v[2] * v[2] + v[3] * v[3]);
                        if (xb) { u32x2 w; w.x = cvtpk(v[0], v[1]); w.y = cvtpk(v[2], v[3]); *(u32x2*)(xb + o) = w; } }
                ss += __shfl_xor(ss, 16); ss += __shfl_xor(ss, 32);
                if (fq == 0) ssqp[(size_t)row * 16 + u.pn * 4 + wc] = ss; }
    }
};
struct EpiFF1 {
    static constexpr bool PERM = true, DUAL = false;
    const float* ssqp; bf16_t* H;
    __device__ __forceinline__ void mid(Acc& acc, const Unit& u, int wr, int wc, int fr, int fq) const {}
    __device__ __forceinline__ void operator()(const Acc& acc, const Unit& u, int wr, int wc, int fr, int fq) const {
        const int row0 = u.pm * BM + wr * 64 + fr, col0 = u.pn * BM + wc * 32 + 8 * fq;
#pragma unroll
        for (int ai = 0; ai < 2; ++ai)
#pragma unroll
            for (int m = 0; m < 4; ++m) { const int row = row0 + ai * HALF + m * 16;
                const f32x4* sp = (const f32x4*)(ssqp + (size_t)row * 16); const f32x4 s = (sp[0] + sp[1]) + (sp[2] + sp[3]);
                const float rstd = __builtin_amdgcn_rsqf(((s[0] + s[1]) + (s[2] + s[3])) * (1.0f / D) + RMS_EPS);
#pragma unroll
                for (int bj = 0; bj < 2; ++bj) { f32x4 v0 = acc[ai][bj][m][0] * rstd, v1 = acc[ai][bj][m][1] * rstd;
#pragma unroll
                    for (int e = 0; e < 4; ++e) { const float a = fmaxf(v0[e], 0.f), b = fmaxf(v1[e], 0.f); v0[e] = a * a; v1[e] = b * b; }
                    *(u32x4*)(H + (size_t)row * FF + col0 + bj * HALF) = pack8(v0, v1); } }
    }
};
}


#define XB_TMO      128
#define XB_XCNT(j)  (256  + 64 * (j))
#define XB_XSUB(j)  (1280 + 64 * (j))
#define XB_XGEN(j)  (2304 + 64 * (j))
#define XB_TOP      3328
#define XB_TOPGEN   3392
#define XCD_BAR_WORDS 3456
#define XB_SPIN_CAP (1u << 18)
__device__ __forceinline__ unsigned xb_ld(unsigned* p)              { return __hip_atomic_load(p, __ATOMIC_RELAXED, __HIP_MEMORY_SCOPE_AGENT); }
__device__ __forceinline__ unsigned xb_add(unsigned* p, unsigned v) { return __hip_atomic_fetch_add(p, v, __ATOMIC_RELAXED, __HIP_MEMORY_SCOPE_AGENT); }
__device__ __forceinline__ unsigned xb_xcc_id() { return (unsigned)__builtin_amdgcn_s_getreg((3 << 11) | 20) & 0xFu; }
#define XB_SPIN(cond, bar) do { unsigned _sp = 0; while (cond) { __builtin_amdgcn_s_sleep(1); \
    if ((++_sp & 255u) == 0u) { if (xb_ld(&(bar)[XB_TMO])) break; if (_sp > XB_SPIN_CAP) { atomicAdd(&(bar)[XB_TMO], 1u); break; } } } } while (0)
struct XcdBarrier { unsigned* bar; unsigned x; volatile LAS unsigned* st; };
__device__ __forceinline__ XcdBarrier xcd_barrier_post(unsigned* bar, volatile LAS unsigned* st) {
    XcdBarrier b; b.bar = bar; b.x = xb_xcc_id(); b.st = st;
    if (threadIdx.x == 0) (void)xb_add(&bar[XB_XCNT(b.x)], 1u);
    return b;
}
__device__ __forceinline__ void xcd_barrier_complete(unsigned* bar, unsigned x, unsigned& nloc, unsigned& nx) {
    const unsigned G = gridDim.x * gridDim.y * gridDim.z;
    unsigned sum, cnt, mine, sp = 0u;
    for (;;) {
        sum = 0u; cnt = 0u; mine = 0u;
#pragma unroll
        for (unsigned j = 0; j < 16; ++j) { const unsigned c = xb_ld(&bar[XB_XCNT(j)]); sum += c; cnt += (c > 0u) ? 1u : 0u; mine = (j == x) ? c : mine; }
        if (sum == G) break;
        __builtin_amdgcn_s_sleep(1);
        if ((++sp & 255u) == 0u) { if (xb_ld(&bar[XB_TMO])) break; if (sp > XB_SPIN_CAP) { atomicAdd(&bar[XB_TMO], 1u); break; } }
    }
    nloc = mine > 0u ? mine : 1u; nx = cnt > 0u ? cnt : 1u;
}
__device__ __forceinline__ void xcd_barrier(const XcdBarrier& b) {
    asm volatile("s_waitcnt vmcnt(0)" ::: "memory");
    __syncthreads();
    if (threadIdx.x == 0) {
        unsigned* bar = b.bar;
        __builtin_amdgcn_s_waitcnt(0);
        unsigned nloc = b.st[0], nx = b.st[1];
        if (nloc == 0u) { xcd_barrier_complete(bar, b.x, nloc, nx); b.st[0] = nloc; b.st[1] = nx; }
        const unsigned old = xb_add(&bar[XB_XSUB(b.x)], 1u);
        const unsigned gen = old / nloc;
        if (old + 1u == (gen + 1u) * nloc) {
            __builtin_amdgcn_fence(__ATOMIC_RELEASE, "agent");
            asm volatile("s_waitcnt vmcnt(0)" ::: "memory");
            const unsigned og = xb_add(&bar[XB_TOP], 1u);
            const unsigned tg = og / nx;
            if (og + 1u == (tg + 1u) * nx) xb_add(&bar[XB_TOPGEN], 1u);
            else XB_SPIN(xb_ld(&bar[XB_TOPGEN]) == tg, bar);
            __builtin_amdgcn_fence(__ATOMIC_ACQUIRE, "agent");
            xb_add(&bar[XB_XGEN(b.x)], 1u);
            asm volatile("s_waitcnt vmcnt(0)" ::: "memory");
        } else {
            XB_SPIN(xb_ld(&bar[XB_XGEN(b.x)]) == gen, bar);
            __builtin_amdgcn_fence(__ATOMIC_ACQUIRE, "agent");
            asm volatile("s_waitcnt vmcnt(0)" ::: "memory");
        }
    }
    __syncthreads();
}

struct Args {
    const float *x, *rel, *g_attn, *w_in, *b_forget, *pe_k, *cw1_k, *cw2_k, *pe_v, *cw1_v, *cw2_v, *w_br_fox, *w_br_nsa, *w_out, *g_mlp, *w_ff1, *w_ff2, *g_final;
    float* out; unsigned char* ws; int ph_lo, ph_hi, li, pad;
};
struct Frame { LAS unsigned char* lds; int tid, lane, wave, G, bid; };

__device__ __forceinline__ float wave_sum(float v) {
#pragma unroll
    for (int o = 1; o < 64; o <<= 1) v += __shfl_xor(v, o);
    return v;
}

__device__ __forceinline__ int win_srccol(int n) {
    if (n < 1536) return n; if (n < 2816) return n + 8; if (n < 4864) return n + 32;
    if (n < 4872) return n - 4864 + 1536; if (n < 4896) return n - 4872 + 2824; return -1;
}
template <bool MAP, bool FRAG = false>
__device__ __forceinline__ void transpose_item(const float* W, int K, int Nsrc, int nblk, bf16_t* WT, LAS float* scr, int item, int lane, const float* kscale) {
    const int kb = item / nblk, nb = item % nblk, k0 = 64 * kb, n0 = 32 * nb;
    const int nd = n0 + (lane & 31), ns = MAP ? win_srccol(nd) : nd;
#pragma unroll 8
    for (int i = 0; i < 32; ++i) { const int kk = 2 * i + (lane >> 5); float v = (ns >= 0) ? W[(size_t)(k0 + kk) * Nsrc + ns] : 0.f; if (kscale) v *= kscale[k0 + kk]; scr[kk * 33 + (lane & 31)] = v; }
    LDS_WAIT(); asm volatile("" ::: "memory");
    const int c = lane & 7;
#pragma unroll
    for (int j = 0; j < 4; ++j) { const int n = (lane >> 3) + 8 * j; const LAS float* s = scr + (8 * c) * 33 + n;
        u32x4 o; o.x = cvtpk(s[0 * 33], s[1 * 33]); o.y = cvtpk(s[2 * 33], s[3 * 33]); o.z = cvtpk(s[4 * 33], s[5 * 33]); o.w = cvtpk(s[6 * 33], s[7 * 33]);
        if (FRAG) { const int nn = n0 + n, kc = (k0 >> 3) + c; *(u32x4*)(WT + ((size_t)(((nn >> 5) * (K >> 4) + (kc >> 1)) * 64 + (kc & 1) * 32 + (nn & 31))) * 8) = o; }
        else *(u32x4*)(WT + (size_t)(n0 + n) * K + k0 + 8 * c) = o; }
    LDS_WAIT(); asm volatile("" ::: "memory");
}
__device__ __forceinline__ int rel_bucket(int n) {
    if (n < 16) return n;
    int lb = 16 + (int)(logf((float)n / 16.0f) / 2.0794415416798357f * 16.0f);
    return lb < 31 ? lb : 31;
}
__device__ __forceinline__ void p0_prologue(const Frame& F, const Args& a) {
    unsigned char* ws = a.ws;
    LAS float* scr = (LAS float*)(F.lds + F.wave * 16384);
    const int gw = F.bid * NWAVES + F.wave, NGW = F.G * NWAVES;
    constexpr int I_IN = 16 * 160, I_BR = 8 * 32, I_OUT = 16 * 32, I_1 = 16 * 128, I_2 = 64 * 32, I_C1 = 32 * 8, I_C2 = 4 * 2;
    constexpr int NITEMS = I_IN + 2 * I_BR + I_OUT + I_1 + I_2 + 2 * I_C1 + 2 * I_C2;
    for (int it = gw; it < NITEMS; it += NGW) {
        int r = it;
        if (r < I_IN) { transpose_item<true>(a.w_in, 1024, 4896, 160, (bf16_t*)(ws + WS_WIN), scr, r, F.lane, nullptr); continue; } r -= I_IN;
        if (r < I_BR) { transpose_item<false>(a.w_br_fox, 512, 1024, 32, (bf16_t*)(ws + WS_WF), scr, r, F.lane, nullptr); continue; } r -= I_BR;
        if (r < I_BR) { transpose_item<false>(a.w_br_nsa, 512, 1024, 32, (bf16_t*)(ws + WS_WN), scr, r, F.lane, nullptr); continue; } r -= I_BR;
        if (r < I_OUT) { transpose_item<false>(a.w_out, 1024, 1024, 32, (bf16_t*)(ws + WS_WOUT), scr, r, F.lane, nullptr); continue; } r -= I_OUT;
        if (r < I_1) { transpose_item<false>(a.w_ff1, 1024, 4096, 128, (bf16_t*)(ws + WS_W1), scr, r, F.lane, a.g_mlp); continue; } r -= I_1;
        if (r < I_2) { transpose_item<false>(a.w_ff2, 4096, 1024, 32, (bf16_t*)(ws + WS_W2), scr, r, F.lane, nullptr); continue; } r -= I_2;
        if (r < I_C1) { transpose_item<false, true>(a.cw1_k, 2048, 256, 8, (bf16_t*)(ws + WS_CW1), scr, r, F.lane, nullptr); continue; } r -= I_C1;
        if (r < I_C1) { transpose_item<false, true>(a.cw1_v, 2048, 256, 8, (bf16_t*)(ws + WS_CW1) + 256 * 2048, scr, r, F.lane, nullptr); continue; } r -= I_C1;
        if (r < I_C2) { transpose_item<false>(a.cw2_k, 256, 64, 2, (bf16_t*)(ws + WS_CW2T), scr, r, F.lane, nullptr); continue; } r -= I_C2;
        transpose_item<false>(a.cw2_v, 256, 64, 2, (bf16_t*)(ws + WS_CW2T) + 64 * 256, scr, r, F.lane, nullptr);
    }
    {
        bf16_t* XN = (bf16_t*)(ws + WS_XN);
        const f32x4* gp = (const f32x4*)a.g_attn + F.lane; f32x4 gv[4];
#pragma unroll
        for (int j = 0; j < 4; ++j) gv[j] = gp[64 * j];
        for (int m = gw; m < M; m += NGW) {
            const f32x4* xr = (const f32x4*)(a.x + (size_t)m * D) + F.lane; f32x4 v[4]; float s = 0.f;
#pragma unroll
            for (int j = 0; j < 4; ++j) { v[j] = xr[64 * j]; s += (v[j][0] * v[j][0] + v[j][1] * v[j][1]) + (v[j][2] * v[j][2] + v[j][3] * v[j][3]); }
            const float rstd = 1.0f / sqrtf(wave_sum(s) * (1.0f / D) + RMS_EPS);
            u32x2* o8 = (u32x2*)(XN + (size_t)m * D) + F.lane;
#pragma unroll
            for (int j = 0; j < 4; ++j) { const f32x4 y = v[j] * rstd * gv[j]; u32x2 w; w.x = cvtpk(y[0], y[1]); w.y = cvtpk(y[2], y[3]); o8[64 * j] = w; }
        }
    }
    for (int it = gw; it < 64; it += NGW) {
        const int kv = it >> 5, jb = (it >> 3) & 3, ic = it & 7; const float* pe = kv ? a.pe_v : a.pe_k; const float* w1 = kv ? a.cw1_v : a.cw1_k;
        const int j = jb * 64 + F.lane; float s = 0.f;
#pragma unroll 8
        for (int i = ic * 256; i < ic * 256 + 256; ++i) s += pe[i] * w1[(size_t)i * 256 + j];
        ((float*)(ws + WS_CB1))[(kv * 8 + ic) * 256 + j] = s;
    }
    for (int i = F.bid * 512 + F.tid; i < 8 * 384; i += F.G * 512) {
        const int h = i / 384, e = i % 384; float v;
        if (e < 256) { const int n = e - 64; v = (n < 0) ? NEGBIG : a.rel[rel_bucket(n < 128 ? n : 128) * 8 + h] * LOG2E; }
        else { const int n = 448 + (e - 256); v = (n < 512) ? a.rel[31 * 8 + h] * LOG2E : NEGBIG; }
        ((float*)(ws + WS_LUT))[i] = v;
    }
}

__device__ __forceinline__ float log_sigmoid_fast(float x) { return fminf(x, 0.f) - __logf(1.0f + __expf(-fabsf(x))); }
__device__ __forceinline__ void scan_seq(const Frame& F, const Args& a, int seq) {
    const int b = seq >> 3, h = seq & 7; const float bf = a.b_forget[h];
    const float* sm = (const float*)(a.ws + WS_SMALL) + ((size_t)b * T + F.tid * 8) * 32 + h;
    float v[8]; float tot = 0.f;
#pragma unroll
    for (int i = 0; i < 8; ++i) v[i] = sm[(size_t)i * 32];
#pragma unroll
    for (int i = 0; i < 8; ++i) { v[i] = log_sigmoid_fast(v[i] + bf); tot += v[i]; }
    float inc = tot;
#pragma unroll
    for (int o = 1; o < 64; o <<= 1) { const float t = __shfl_up(inc, o); if (F.lane >= o) inc += t; }
    LAS float* wt = (LAS float*)F.lds;
    __syncthreads();
    if (F.lane == 63) wt[F.wave] = inc;
    __syncthreads();
    float base = 0.f;
#pragma unroll
    for (int w = 0; w < 8; ++w) if (w < F.wave) base += wt[w];
    float run = base + inc - tot;
    u32x4* fb = (u32x4*)((bf16_t*)(a.ws + WS_FB) + ((size_t)seq * T + F.tid * 8) * 16);
#pragma unroll
    for (int i = 0; i < 8; ++i) {
        run += v[i];
        const float x = -run * LOG2E;
        const unsigned w0 = cvtpk(x, 0.f) & 0xffffu; const float r1 = x - __uint_as_float(w0 << 16);
        const unsigned w1 = cvtpk(r1, 0.f) & 0xffffu; const float r2 = r1 - __uint_as_float(w1 << 16);
        const unsigned w2 = cvtpk(r2, 0.f) & 0xffffu;
        fb[2 * i] = (u32x4){w0 | (w1 << 16), w2, 0u, 0u}; fb[2 * i + 1] = (u32x4){0u, 0u, 0u, 0u};
    }
    __syncthreads();
}
__device__ __forceinline__ void compress_unit(const Frame& F, const Args& a, int unit) {
    const int kv = unit >> 6, bg = (unit >> 3) & 7, ct = unit & 7, c0 = ct * 32;
    const int lane = F.lane, r32 = lane & 31, hi = lane >> 5, w = F.wave;
    const bf16_t* data = (const bf16_t*)(a.ws + WS_KV6) + (size_t)kv * KV6_ELEMS + (size_t)bg * T * 64;
    const bf16_t* w1t = (const bf16_t*)(a.ws + WS_CW1) + (size_t)kv * 256 * 2048;
    const bf16_t* w2t = (const bf16_t*)(a.ws + WS_CW2T) + (size_t)kv * 64 * 256;
    const float* cb1 = (const float*)(a.ws + WS_CB1) + kv * 2048;
    LAS float* red = (LAS float*)F.lds;
    for (int i = F.tid; i < 2048; i += 512) red[i] = 0.f;
    LAS unsigned char* xs = F.lds + 8192;
    { const u32x4* src = (const u32x4*)(data + (size_t)c0 * 1024);
      for (int ch = F.tid; ch < 33 * 128; ch += 512) { const u32x4 v = src[ch]; *(LAS u32x4*)(xs + (ch >> 7) * 2064 + (ch & 127) * 16) = v; } }
    const bf16_t* ap = w1t + ((size_t)w * 128 * 64 + lane) * 8;
    const LAS unsigned char* bp = xs + r32 * 2064 + hi * 16;
    f32x16 h0 = {};
    bf16x8 A0[8], A1[8];
#pragma unroll
    for (int j = 0; j < 8; ++j) A0[j] = *(const bf16x8*)(ap + j * 512);
    __syncthreads();
#pragma unroll 1
    for (int blk = 0; blk < 16; blk += 2) {
        const LAS unsigned char* b0p = bp + (blk >> 3) * 2064 + (blk & 7) * 256;
#pragma unroll
        for (int j = 0; j < 8; ++j) A1[j] = *(const bf16x8*)(ap + (blk * 8 + 8 + j) * 512);
#pragma unroll
        for (int j = 0; j < 8; ++j) h0 = __builtin_amdgcn_mfma_f32_32x32x16_bf16(A0[j], *(const LAS bf16x8*)(b0p + j * 32), h0, 0, 0, 0);
        if (blk + 2 < 16) {
#pragma unroll
            for (int j = 0; j < 8; ++j) A0[j] = *(const bf16x8*)(ap + (blk * 8 + 16 + j) * 512);
        }
#pragma unroll
        for (int j = 0; j < 8; ++j) h0 = __builtin_amdgcn_mfma_f32_32x32x16_bf16(A1[j], *(const LAS bf16x8*)(b0p + 256 + j * 32), h0, 0, 0, 0);
    }
#pragma unroll
    for (int r = 0; r < 16; ++r) { const float* cp = cb1 + 32 * w + crow(r, hi); float bj = 0.f;
#pragma unroll
        for (int ic = 0; ic < 8; ++ic) bj += cp[ic * 256];
        const float x0 = h0[r] + bj; h0[r] = x0 * fsigmoid(x0); }
    f32x16 po[2] = {};
#pragma unroll
    for (int s = 0; s < 2; ++s) {
        u32x4 t0;
        t0.x = cvtpk(h0[8 * s + 0], h0[8 * s + 1]); t0.y = cvtpk(h0[8 * s + 2], h0[8 * s + 3]); t0.z = cvtpk(h0[8 * s + 4], h0[8 * s + 5]); t0.w = cvtpk(h0[8 * s + 6], h0[8 * s + 7]);
        const bf16x8 xb0 = __builtin_bit_cast(bf16x8, t0);
#pragma unroll
        for (int dt = 0; dt < 2; ++dt) {
            const bf16_t* wp = w2t + (size_t)(dt * 32 + r32) * 256 + 32 * w + 16 * s + 4 * hi;
            const u32x2 lo = *(const u32x2*)wp, hi2 = *(const u32x2*)(wp + 8);
            const bf16x8 wa = __builtin_bit_cast(bf16x8, (u32x4){lo.x, lo.y, hi2.x, hi2.y});
            po[dt] = __builtin_amdgcn_mfma_f32_32x32x16_bf16(wa, xb0, po[dt], 0, 0, 0);
        }
    }
    __syncthreads();
#pragma unroll
    for (int dt = 0; dt < 2; ++dt)
#pragma unroll
        for (int r = 0; r < 16; ++r) __hip_atomic_fetch_add(red + r32 * 64 + dt * 32 + crow(r, hi), po[dt][r], __ATOMIC_RELAXED, __HIP_MEMORY_SCOPE_WORKGROUP);
    __syncthreads();
    if (F.tid < 256) { const int c = F.tid >> 3, dc = (F.tid & 7) * 8; const LAS float* s = red + c * 64 + dc;
      u32x4 o; o.x = cvtpk(s[0], s[1]); o.y = cvtpk(s[2], s[3]); o.z = cvtpk(s[4], s[5]); o.w = cvtpk(s[6], s[7]);
      if (c0 + c == 255) o = (u32x4){0u, 0u, 0u, 0u};
      *(u32x4*)((bf16_t*)(a.ws + WS_KC) + ((size_t)(kv * 8 + bg) * 256 + c0 + c) * 64 + dc) = o; }
    __syncthreads();
}

__device__ __forceinline__ void glds16(const void* gsrc, unsigned lds_dst) { unsigned keep;
    asm volatile("s_mov_b32 %0, m0\n\ts_mov_b32 m0, %2\n\ts_nop 0\n\tglobal_load_lds_dwordx4 %1, off\n\ts_mov_b32 m0, %0" : "=&s"(keep) : "v"(gsrc), "s"(lds_dst) : "memory"); }
__device__ __forceinline__ float rowmax32(const f32x16& p0, const f32x16& p1) {
    float a = __builtin_fmaxf(p0[0], p1[0]);
#pragma unroll
    for (int r = 1; r < 16; ++r) a = __builtin_fmaxf(__builtin_fmaxf(a, p0[r]), p1[r]);
    auto rr = __builtin_amdgcn_permlane32_swap(__float_as_uint(a), __float_as_uint(a), false, false);
    return fmaxf(__uint_as_float(rr[0]), __uint_as_float(rr[1]));
}
__device__ __forceinline__ float swap_other(float v, int hi) {
    auto rr = __builtin_amdgcn_permlane32_swap(__float_as_uint(v), __float_as_uint(v), false, false);
    return __uint_as_float(hi ? rr[0] : rr[1]);
}
__device__ __forceinline__ unsigned swap_other_u(unsigned v, int hi) {
    auto rr = __builtin_amdgcn_permlane32_swap(v, v, false, false);
    return hi ? rr[0] : rr[1];
}
template <int NK>
__device__ __forceinline__ void qkt(f32x16& p0, f32x16& p1, const LAS unsigned char* Kslot, const bf16x8* qr, float cinit, int r32, int hi) {
    unsigned kbu = (unsigned)(uintptr_t)(Kslot + hi * 1024 + r32 * 16); OPAQUE(kbu); const LAS unsigned char* kb = (const LAS unsigned char*)kbu;
    f32x16 c;
#pragma unroll
    for (int r = 0; r < 16; ++r) c[r] = cinit;
    p0 = c; p1 = c;
    bf16x8 b0 = *(const LAS bf16x8*)(kb), b1 = *(const LAS bf16x8*)(kb + 512);
#pragma unroll
    for (int d0 = 0; d0 < NK; ++d0) {
        bf16x8 n0 = b0, n1 = b1;
        if (d0 + 1 < NK) { n0 = *(const LAS bf16x8*)(kb + (d0 + 1) * 2048); n1 = *(const LAS bf16x8*)(kb + (d0 + 1) * 2048 + 512); }
        p0 = __builtin_amdgcn_mfma_f32_32x32x16_bf16(b0, qr[d0], p0, 0, 0, 0);
        p1 = __builtin_amdgcn_mfma_f32_32x32x16_bf16(b1, qr[d0], p1, 0, 0, 0);
        SBAR();
        b0 = n0; b1 = n1;
    }
}
__device__ __forceinline__ void pv(f32x16* o, unsigned vb, bf16x8 pa0, bf16x8 pa1, bf16x8 pa2, bf16x8 pa3) {
#pragma unroll
    for (int d0 = 0; d0 < 2; ++d0) { s16x4 lo[4], hi[4];
#pragma unroll
        for (int ks = 0; ks < 4; ++ks) {
            asm volatile("ds_read_b64_tr_b16 %0,%1 offset:%c2" : "=&v"(lo[ks]) : "v"(vb), "i"(d0 * 4096 + ks * 1024) : "memory");
            asm volatile("ds_read_b64_tr_b16 %0,%1 offset:%c2" : "=&v"(hi[ks]) : "v"(vb), "i"(d0 * 4096 + ks * 1024 + 512) : "memory"); }
        asm volatile("s_waitcnt lgkmcnt(0)" ::: "memory"); SBAR();
#define PK(k) (bf16x8){lo[k][0], lo[k][1], lo[k][2], lo[k][3], hi[k][0], hi[k][1], hi[k][2], hi[k][3]}
        o[d0] = __builtin_amdgcn_mfma_f32_32x32x16_bf16(pa0, PK(0), o[d0], 0, 0, 0);
        o[d0] = __builtin_amdgcn_mfma_f32_32x32x16_bf16(pa1, PK(1), o[d0], 0, 0, 0);
        o[d0] = __builtin_amdgcn_mfma_f32_32x32x16_bf16(pa2, PK(2), o[d0], 0, 0, 0);
        o[d0] = __builtin_amdgcn_mfma_f32_32x32x16_bf16(pa3, PK(3), o[d0], 0, 0, 0);
#undef PK
    }
}
constexpr float SM_THR = 8.0f;
__device__ __forceinline__ float softmax_pv(f32x16& p0, f32x16& p1, float& mhat, float& l, f32x16* o, volatile LAS float* wsf, unsigned vb, int r32, int hi, float& dl) {
    const float rm = rowmax32(p0, p1);
    float f = 1.0f; dl = 0.f;
    if (__any(rm > SM_THR)) {
        dl = fmaxf(rm, 0.f); mhat += dl;
#pragma unroll
        for (int r = 0; r < 16; ++r) { p0[r] -= dl; p1[r] -= dl; }
        f = __builtin_amdgcn_exp2f(-dl); l *= f;
        if (hi == 0) wsf[r32] = f;
        LDS_WAIT();
        { unsigned wb = (unsigned)(uintptr_t)(wsf + 4 * hi); OPAQUE(wb); volatile LAS float* wq = (volatile LAS float*)wb;
#pragma unroll
        for (int r = 0; r < 16; ++r) { const float ff = wq[(r & 3) + 8 * (r >> 2)]; o[0][r] *= ff; o[1][r] *= ff; } }
    }
    float s = 0.f;
#pragma unroll
    for (int r = 0; r < 16; ++r) { p0[r] = __builtin_amdgcn_exp2f(p0[r]); p1[r] = __builtin_amdgcn_exp2f(p1[r]); s += p0[r] + p1[r]; }
    l += s;
    u32x4 w0, w1, w2, w3;
    w0 = (u32x4){cvtpk(p0[0], p0[1]), cvtpk(p0[2], p0[3]), cvtpk(p0[4], p0[5]), cvtpk(p0[6], p0[7])};
    w1 = (u32x4){cvtpk(p0[8], p0[9]), cvtpk(p0[10], p0[11]), cvtpk(p0[12], p0[13]), cvtpk(p0[14], p0[15])};
    w2 = (u32x4){cvtpk(p1[0], p1[1]), cvtpk(p1[2], p1[3]), cvtpk(p1[4], p1[5]), cvtpk(p1[6], p1[7])};
    w3 = (u32x4){cvtpk(p1[8], p1[9]), cvtpk(p1[10], p1[11]), cvtpk(p1[12], p1[13]), cvtpk(p1[14], p1[15])};
    pv(o, vb, __builtin_bit_cast(bf16x8, w0), __builtin_bit_cast(bf16x8, w1), __builtin_bit_cast(bf16x8, w2), __builtin_bit_cast(bf16x8, w3));
    return f;
}
__device__ __forceinline__ void sub_all(f32x16& p0, f32x16& p1, float dl) {
#pragma unroll
    for (int r = 0; r < 16; ++r) { p0[r] -= dl; p1[r] -= dl; }
}
__device__ __forceinline__ void lut_bias(f32x16& p0, f32x16& p1, const LAS float* lut, int d0, int hi) {
    const LAS float* lp = lut + (d0 - 4 * hi - 63);
#pragma unroll
    for (int r = 0; r < 16; ++r) { const int ko = (r & 3) + 8 * (r >> 2);
        p0[r] += lp[63 - ko]; p1[r] += lp[63 - ko - 32]; }
}
__device__ __forceinline__ void lut_bias_cmp(f32x16& p0, f32x16& p1, const LAS float* lut, int d0, int hi) {
#pragma unroll
    for (int r = 0; r < 16; ++r) { const int ko = (r & 3) + 8 * (r >> 2) + 4 * hi;
        int n0 = d0 - 16 * ko, n1 = n0 - 512;
        n0 = n0 < -1 ? -1 : (n0 > 128 ? 128 : n0); n1 = n1 < -1 ? -1 : (n1 > 128 ? 128 : n1);
        p0[r] += lut[n0]; p1[r] += lut[n1]; }
}
__device__ __forceinline__ void cmask(f32x16& p0, f32x16& p1, int jb, int qrel, int hi) {
    const int kb = 64 * jb + 4 * hi;
#pragma unroll
    for (int r = 0; r < 16; ++r) { const int kv = kb + (r & 3) + 8 * (r >> 2); if (kv > qrel) p0[r] = NEGBIG; if (kv + 32 > qrel) p1[r] = NEGBIG; }
}
#define WAIT_BAR0() asm volatile("s_waitcnt vmcnt(0) lgkmcnt(0)\n\ts_barrier" ::: "memory")

__device__ __forceinline__ void fox_unit(const Frame& F, const Args& a, int b, int h, int qb) {
    int lane = F.lane; OPAQUE(lane);
    const int r32 = lane & 31, hi = lane >> 5, wid = F.wave;
    const unsigned lds0 = (unsigned)(uintptr_t)F.lds;
    const bf16_t* FQ = (const bf16_t*)(a.ws + WS_FQ); const bf16_t* FK = (const bf16_t*)(a.ws + WS_FK); const bf16_t* FV = (const bf16_t*)(a.ws + WS_FV);
    const bf16_t* FB = (const bf16_t*)(a.ws + WS_FB) + (size_t)(b * 8 + h) * T * 16;
    const long rowbase = (long)b * T; const int q0 = qb * 256;
    const bf16_t* Kh = FK + rowbase * 512 + h * 64; const bf16_t* Vh = FV + rowbase * 512 + h * 64;
    const int koff = lane * 512 + wid * 8, voff = (16 * (wid & 3) + (lane >> 2)) * 512 + (wid >> 2) * 32 + (lane & 3) * 8, foff = lane * 16 + (wid & 1) * 8;
    const unsigned kdst = lds0 + L_K + wid * 1024, vdst = lds0 + L_V + wid * 1024, fdst = lds0 + L_K + 8192 + (wid & 1) * 1024;
    const unsigned vb0 = lds0 + L_V + ((lane >> 4) & 1) * 32 + (lane & 3) * 8 + (4 * hi + ((lane & 15) >> 2)) * 64;
    volatile LAS float* wsf = (volatile LAS float*)(F.lds + L_WSF) + wid * 64;
    const int NT = (q0 + 256) / 64;
#define FOX_DMA_K(t, s) do { int ko_ = koff; OPAQUE(ko_); glds16(Kh + (long)(t) * 64 * 512 + ko_, (unsigned)__builtin_amdgcn_readfirstlane(kdst + (s) * KSLOT)); \
        if (wid < 2) { int fo_ = foff; OPAQUE(fo_); glds16(FB + (long)(t) * 64 * 16 + fo_, (unsigned)__builtin_amdgcn_readfirstlane(fdst + (s) * KSLOT)); } } while (0)
#define FOX_DMA_V(t, s) do { int vo_ = voff; OPAQUE(vo_); glds16(Vh + (long)(t) * 64 * 512 + vo_, (unsigned)__builtin_amdgcn_readfirstlane(vdst + (s) * VSLOT)); } while (0)
    __syncthreads();
    FOX_DMA_K(NT - 1, 0); FOX_DMA_V(NT - 1, 0); FOX_DMA_K(NT - 2, 1);
    bf16x8 qr[5];
    { const bf16_t* Qw = FQ + (rowbase + q0 + wid * 32 + r32) * 512 + h * 64;
#pragma unroll
      for (int d0 = 0; d0 < 4; ++d0) qr[d0] = *(const bf16x8*)(Qw + d0 * 16 + hi * 8);
      const short one = (short)0x3f80; qr[4] = hi ? (bf16x8){0, 0, 0, 0, 0, 0, 0, 0} : (bf16x8){one, one, one, 0, 0, 0, 0, 0}; }
    float mhat = -100.f, l = 0.f; f32x16 o[2]; o[0] = f32x16{}; o[1] = f32x16{};
    const int qrel = wid * 32 + r32;
    f32x16 pA0, pA1, pB0, pB1;
    WAIT_BAR0();
    qkt<5>(pA0, pA1, F.lds + L_K, qr, -mhat, r32, hi);
    int ks = 1, vs = 0;
#define FOX_STEP(PC0, PC1, PN0, PN1, i) do { \
        WAIT_BAR0(); \
        if ((i) + 2 < NT) FOX_DMA_K(NT - 3 - (i), ks == 2 ? 0 : ks + 1); \
        if ((i) + 1 < NT) FOX_DMA_V(NT - 2 - (i), vs ^ 1); \
        if ((i) + 1 < NT) qkt<5>(PN0, PN1, F.lds + L_K + ks * KSLOT, qr, -mhat, r32, hi); \
        SBAR(); \
        { const int jb = 3 - (i); if (jb >= 0) cmask(PC0, PC1, jb, qrel, hi); } \
        float dl_; softmax_pv(PC0, PC1, mhat, l, o, wsf, vb0 + vs * VSLOT, r32, hi, dl_); \
        SBAR(); \
        if (__any(dl_ != 0.f)) sub_all(PN0, PN1, dl_); \
        ks = (ks == 2) ? 0 : ks + 1; vs ^= 1; } while (0)
#pragma unroll 1
    for (int i = 0; i < NT; i += 2) {
        FOX_STEP(pA0, pA1, pB0, pB1, i);
        FOX_STEP(pB0, pB1, pA0, pA1, i + 1);
    }
#undef FOX_STEP
#undef FOX_DMA_K
#undef FOX_DMA_V
    l += swap_other(l, hi);
    if (hi == 0) wsf[32 + r32] = l; LDS_WAIT();
    LAS bf16_t* st = (LAS bf16_t*)(F.lds + L_OST) + wid * 2048;
#pragma unroll
    for (int r = 0; r < 16; ++r) { const int orow = crow(r, hi); const float rl = __builtin_amdgcn_rcpf(wsf[32 + orow]);
#pragma unroll
        for (int d0 = 0; d0 < 2; ++d0) { const unsigned w = cvtpk(o[d0][r] * rl, 0.f); st[orow * 64 + d0 * 32 + r32] = (bf16_t)(w & 0xffffu); } }
    LDS_WAIT();
    bf16_t* Ow = (bf16_t*)(a.ws + WS_OFOX) + (rowbase + q0 + wid * 32) * 512 + h * 64;
    int l2 = lane; OPAQUE(l2);
#pragma unroll
    for (int i = 0; i < 4; ++i) { const int row = i * 8 + (l2 >> 3), ch = l2 & 7; const u32x4 v = *(const LAS u32x4*)(st + row * 64 + ch * 8); *(u32x4*)(Ow + (long)row * 512 + ch * 8) = v; }
}

__device__ __forceinline__ void nsa_unit(const Frame& F, const Args& a, int bg, int qb) {
    const int wid = F.wave;
    const int b = bg >> 1, g = bg & 1, q0 = qb * 64;
#define NSA_CTX() int lane = F.lane; OPAQUE(lane); const int r32 = lane & 31, hi = lane >> 5; \
    const unsigned lds0 = (unsigned)(uintptr_t)F.lds; \
    const int tok = r32 & 7, hh = r32 >> 3, h = g * 4 + hh, qpos = q0 + 8 * wid + tok; (void)h; (void)qpos; \
    const int koff = lane * 64 + wid * 8, voff = (16 * (wid & 3) + (lane >> 2)) * 64 + (wid >> 2) * 32 + (lane & 3) * 8; (void)koff; (void)voff; \
    const unsigned kdst = lds0 + L_K + wid * 1024, vdst = lds0 + L_V + wid * 1024; (void)kdst; (void)vdst; \
    const unsigned vb0 = lds0 + L_V + ((lane >> 4) & 1) * 32 + (lane & 3) * 8 + (4 * hi + ((lane & 15) >> 2)) * 64; (void)vb0; \
    volatile LAS float* wsf = (volatile LAS float*)(F.lds + L_WSF) + wid * 64; (void)wsf; \
    LAS float* ost = (LAS float*)(F.lds + L_OST) + wid * 2048; (void)ost; \
    const LAS float* lut = (const LAS float*)(F.lds + L_LUT) + hh * 384 + 64; (void)lut
#define NSA_DMA(Kp, Vp, t, s) do { glds16((Kp) + (size_t)(t) * 4096 + koff, (unsigned)__builtin_amdgcn_readfirstlane(kdst + (s) * KSLOT)); glds16((Vp) + (size_t)(t) * 4096 + voff, (unsigned)__builtin_amdgcn_readfirstlane(vdst + (s) * VSLOT)); } while (0)
#define BR_BEGIN() do { mhat = -100.f; l = 0.f; o[0] = f32x16{}; o[1] = f32x16{}; } while (0)
#define BR_END(gate, FIRST) do { l += swap_other(l, hi); const float fac = (l > 0.f) ? (gate) * __builtin_amdgcn_rcpf(l) : 0.f; \
        if (hi == 0) wsf[r32] = fac; LDS_WAIT(); \
        unsigned wb_ = (unsigned)(uintptr_t)(wsf + 4 * hi), ob_ = (unsigned)(uintptr_t)(ost + 4 * hi * 64 + r32); OPAQUE(wb_); OPAQUE(ob_); \
        volatile LAS float* wq_ = (volatile LAS float*)wb_; LAS float* oq_ = (LAS float*)ob_; \
        _Pragma("unroll") for (int r = 0; r < 16; ++r) { const float ff = wq_[(r & 3) + 8 * (r >> 2)]; LAS float* dst = oq_ + ((r & 3) + 8 * (r >> 2)) * 64; \
            if (FIRST) { dst[0] = o[0][r] * ff; dst[32] = o[1][r] * ff; } else { dst[0] += o[0][r] * ff; dst[32] += o[1][r] * ff; } } LDS_WAIT(); } while (0)
    const bf16_t* KV6 = (const bf16_t*)(a.ws + WS_KV6);
    __syncthreads();
    { const float* lg = (const float*)(a.ws + WS_LUT) + (size_t)g * 4 * 384; LAS float* lutl = (LAS float*)(F.lds + L_LUT); for (int i = F.tid; i < 4 * 384; i += 512) lutl[i] = lg[i]; }
    bf16x8 qr[4];
    float gate0, gate1, gate2, b31;
    { NSA_CTX();
      const size_t row = (size_t)b * T + qpos;
      const bf16_t* Qw = (const bf16_t*)(a.ws + WS_NQ) + row * 512 + h * 64;
#pragma unroll
      for (int d0 = 0; d0 < 4; ++d0) qr[d0] = *(const bf16x8*)(Qw + d0 * 16 + hi * 8);
      const float* gl = (const float*)(a.ws + WS_SMALL) + row * 32 + 8 + h * 3;
      gate0 = fsigmoid(gl[0]); gate1 = fsigmoid(gl[1]); gate2 = fsigmoid(gl[2]);
      b31 = ((const float*)(a.ws + WS_LUT))[(size_t)h * 384 + 64 + 128]; }
    float mhat, l; f32x16 o[2];

    unsigned long long selmask;
    {
        NSA_CTX();
        const bf16_t* KCp = (const bf16_t*)(a.ws + WS_KC) + (size_t)bg * 256 * 64; const bf16_t* VCp = KCp + (size_t)8 * 256 * 64;
        const int cmax = (q0 + 63 - 31) >> 4, ncmp = (cmax >> 6) + 1;
        float imp[32];
#pragma unroll
        for (int i = 0; i < 32; ++i) imp[i] = 0.f;
        float carry = 0.f;
        BR_BEGIN();
        __syncthreads();
        NSA_DMA(KCp, VCp, 0, 0);
#pragma unroll
        for (int i = 0; i < 4; ++i) {
            if (i < ncmp) {
                WAIT_BAR0();
                if (i + 1 < ncmp) NSA_DMA(KCp, VCp, i + 1, (i + 1) & 1);
                f32x16 p0, p1;
                qkt<4>(p0, p1, F.lds + L_K + (i & 1) * KSLOT, qr, -mhat, r32, hi);
                lut_bias_cmp(p0, p1, lut, qpos - 31 - 1024 * i, hi);
                float dl_; const float f = softmax_pv(p0, p1, mhat, l, o, wsf, vb0 + (i & 1) * VSLOT, r32, hi, dl_);
#pragma unroll
                for (int k = 0; k < 8 * i; ++k) imp[k] *= f;
                carry *= f;
                float e3[8];
#pragma unroll
                for (int k = 0; k < 8; ++k) { const f32x16& pp = (k < 4) ? p0 : p1; const int rb = 4 * (k & 3);
                    imp[8 * i + k] = (pp[rb] + pp[rb + 1]) + (pp[rb + 2] + pp[rb + 3]); e3[k] = pp[rb + 3]; }
                float pe3[8];
#pragma unroll
                for (int k = 0; k < 8; ++k) pe3[k] = swap_other(e3[k], hi);
#pragma unroll
                for (int k = 0; k < 8; ++k) imp[8 * i + k] += hi ? pe3[k] : (k == 0 ? carry : pe3[k - 1]);
                carry = pe3[7];
            }
        }
        BR_END(gate0, true);
        const float rl = (l > 0.f) ? __builtin_amdgcn_rcpf(l) : 0.f;
        const int cur = qpos >> 6;
        unsigned key[32];
#pragma unroll
        for (int i = 0; i < 32; ++i) { float v = imp[i] * rl; v += __shfl_xor(v, 8); v += __shfl_xor(v, 16);
            const int s = 16 * (i >> 3) + 2 * (i & 7) + hi;
            unsigned kbits = (__float_as_uint(v) & ~63u) | (unsigned)(63 - s);
            if (s == 0 || s == cur || s == cur - 1) kbits = 0x7f000000u | (unsigned)(63 - s);
            if (s > cur) kbits = 0u;
            key[i] = kbits; }
        unsigned long long msk = 0ull;
#pragma unroll 1
        for (int pass = 0; pass < 16; ++pass) {
            unsigned mx = key[0];
#pragma unroll
            for (int i = 1; i < 32; ++i) mx = mx > key[i] ? mx : key[i];
            const unsigned om = swap_other_u(mx, hi); mx = mx > om ? mx : om;
            if (mx != 0u) msk |= 1ull << (63 - (int)(mx & 63u));
#pragma unroll
            for (int i = 0; i < 32; ++i) key[i] = (key[i] == mx) ? 0u : key[i];
        }
        selmask = msk;
    }
#define NSA_STEP(Kp, Vp, NTT, TILE, CINIT, BIAS, PC0, PC1, PN0, PN1, i) do { \
        WAIT_BAR0(); \
        if ((i) + 2 < (NTT)) glds16((Kp) + (size_t)(TILE((i) + 2)) * 4096 + koff, (unsigned)__builtin_amdgcn_readfirstlane(kdst + (ks == 2 ? 0 : ks + 1) * KSLOT)); \
        if ((i) + 1 < (NTT)) glds16((Vp) + (size_t)(TILE((i) + 1)) * 4096 + voff, (unsigned)__builtin_amdgcn_readfirstlane(vdst + (vs ^ 1) * VSLOT)); \
        if ((i) + 1 < (NTT)) { const int t1_ = TILE((i) + 1); qkt<4>(PN0, PN1, F.lds + L_K + ks * KSLOT, qr, CINIT(t1_), r32, hi); } \
        SBAR(); \
        { const int t_ = TILE(i); BIAS(PC0, PC1, t_); } \
        float dl_; softmax_pv(PC0, PC1, mhat, l, o, wsf, vb0 + vs * VSLOT, r32, hi, dl_); \
        SBAR(); \
        if (__any(dl_ != 0.f)) sub_all(PN0, PN1, dl_); \
        ks = (ks == 2) ? 0 : ks + 1; vs ^= 1; } while (0)
#define NSA_LOOP(Kp, Vp, NTT, TILE, CINIT, BIAS) do { \
        f32x16 pA0, pA1, pB0, pB1; int ks = 1, vs = 0; \
        __syncthreads(); \
        glds16((Kp) + (size_t)(TILE(0)) * 4096 + koff, (unsigned)__builtin_amdgcn_readfirstlane(kdst)); glds16((Vp) + (size_t)(TILE(0)) * 4096 + voff, (unsigned)__builtin_amdgcn_readfirstlane(vdst)); \
        if ((NTT) > 1) glds16((Kp) + (size_t)(TILE(1)) * 4096 + koff, (unsigned)__builtin_amdgcn_readfirstlane(kdst + KSLOT)); \
        WAIT_BAR0(); \
        { const int t0_ = TILE(0); qkt<4>(pA0, pA1, F.lds + L_K, qr, CINIT(t0_), r32, hi); } \
        int i_ = 0; \
        _Pragma("unroll 1") for (; i_ + 1 < (NTT); i_ += 2) { NSA_STEP(Kp, Vp, NTT, TILE, CINIT, BIAS, pA0, pA1, pB0, pB1, i_); NSA_STEP(Kp, Vp, NTT, TILE, CINIT, BIAS, pB0, pB1, pA0, pA1, i_ + 1); } \
        if (i_ < (NTT)) NSA_STEP(Kp, Vp, NTT, TILE, CINIT, BIAS, pA0, pA1, pB0, pB1, i_); } while (0)
#ifndef NO_SEL
    {
        NSA_CTX();
        const bf16_t* KSL = KV6 + 2 * KV6_ELEMS + (size_t)bg * T * 64; const bf16_t* VSL = KV6 + 3 * KV6_ELEMS + (size_t)bg * T * 64;
        BR_BEGIN();
        const int nt = qb + 1;
#define SEL_TILE(i) (i)
#define SEL_CINIT(t) (((selmask >> (t)) & 1ull) ? (((t) >= qb - 2) ? -mhat : b31 - mhat) : NEGBIG)
#define SEL_BIAS(P0, P1, t) do { if ((t) >= qb - 2) lut_bias(P0, P1, lut, qpos - 64 * (t), hi); } while (0)
        NSA_LOOP(KSL, VSL, nt, SEL_TILE, SEL_CINIT, SEL_BIAS);
#undef SEL_TILE
#undef SEL_CINIT
#undef SEL_BIAS
        BR_END(gate1, false);
    }
#endif
#ifndef NO_WIN
    {
        NSA_CTX();
        const bf16_t* KWN = KV6 + 4 * KV6_ELEMS + (size_t)bg * T * 64; const bf16_t* VWN = KV6 + 5 * KV6_ELEMS + (size_t)bg * T * 64;
        const LAS float* lutw = lut - 64 + 256 - 448;
        BR_BEGIN();
        const int t0 = qb >= 8 ? qb - 8 : 0, nt = qb - t0 + 1;
#define WIN_TILE(i) (t0 + (i))
#define WIN_CINIT(t) ((((t) >= qb - 2) || ((t) == qb - 8)) ? -mhat : b31 - mhat)
#define WIN_BIAS(P0, P1, t) do { if ((t) >= qb - 2) lut_bias(P0, P1, lut, qpos - 64 * (t), hi); else if ((t) == qb - 8) lut_bias(P0, P1, lutw, qpos - 64 * (t), hi); } while (0)
        NSA_LOOP(KWN, VWN, nt, WIN_TILE, WIN_CINIT, WIN_BIAS);
#undef WIN_TILE
#undef WIN_CINIT
#undef WIN_BIAS
        BR_END(gate2, false);
    }
#endif
    {
        NSA_CTX();
        bf16_t* O = (bf16_t*)(a.ws + WS_ONSA);
#pragma unroll
        for (int i = 0; i < 4; ++i) { const int rr = i * 8 + (lane >> 3), ch = lane & 7; const LAS f32x4* sp = (const LAS f32x4*)(ost + rr * 64 + ch * 8); const f32x4 v0 = sp[0], v1 = sp[1];
            const int tk = rr & 7, h2 = g * 4 + (rr >> 3);
            *(u32x4*)(O + ((size_t)b * T + q0 + 8 * wid + tk) * 512 + h2 * 64 + ch * 8) = pg8::pack8(v0, v1); }
    }
#undef NSA_CTX
#undef NSA_STEP
#undef NSA_LOOP
#undef NSA_DMA
#undef BR_BEGIN
#undef BR_END
}

__global__ void __launch_bounds__(NWAVES * 64, 2) fwd_kernel(Args a) {
    extern __shared__ __attribute__((aligned(16))) unsigned char lds_raw[];
    Frame F; F.lds = (LAS unsigned char*)lds_raw; F.tid = threadIdx.x; F.lane = F.tid & 63; F.wave = __builtin_amdgcn_readfirstlane(F.tid >> 6); F.G = gridDim.x; F.bid = blockIdx.x;
    unsigned char* ws = a.ws;
    const int lo = a.ph_lo, hi = a.ph_hi;
#ifndef PH_MASK
#define PH_MASK 0x1ff
#endif
#define IN(k) (((PH_MASK >> (k)) & 1) && lo <= (k) && (k) < hi)
    volatile LAS unsigned* MISC = (volatile LAS unsigned*)(F.lds + L_MISC);
    if (F.tid < 16) MISC[F.tid] = 0u;
    __syncthreads();
    const XcdBarrier xbar = xcd_barrier_post((unsigned*)(ws + WS_BAR) + a.li * XCD_BAR_WORDS, MISC);
#define SEAM(k) do { if (IN(k) && IN((k) + 1)) xcd_barrier(xbar); } while (0)
    if (IN(0)) { p0_prologue(F, a); } SEAM(0);
    if (IN(1)) {
        pg8::Gemm g{(const bf16_t*)(ws + WS_XN), nullptr, (const bf16_t*)(ws + WS_WIN), nullptr, M, NIN, D};
        pg8::StaticOrder S; S.init(M, NIN, F.G, F.bid, 0);
        pg8::EpiQKV E{(bf16_t*)(ws + WS_FQ), (bf16_t*)(ws + WS_FK), (bf16_t*)(ws + WS_FV), (bf16_t*)(ws + WS_NQ), (bf16_t*)(ws + WS_KV6), (bf16_t*)(ws + WS_GA), (bf16_t*)(ws + WS_GB), (float*)(ws + WS_SMALL)};
        pg8::gemm_phase<pg8::EpiQKV, true, true>(F.lds, g, S, E);
    } SEAM(1);
    if (IN(2)) {
        for (int u = F.bid; u < 128; u += F.G) compress_unit(F, a, u);
        for (int s = 0; s < 32; ++s) if (((s + 128) % F.G) == F.bid) scan_seq(F, a, s);
    } SEAM(2);
    if (IN(3)) {
        for (int v = F.bid; v < 256; v += F.G) {
#ifndef NO_FOX
            { const int bh = v >> 3, s = v & 7; for (int k = 0; k < 2; ++k) fox_unit(F, a, bh >> 3, bh & 7, k ? 15 - s : s); }
#endif
#ifndef NO_NSA
            { const int bg = v >> 5, s = v & 31; for (int k = 0; k < 2; ++k) nsa_unit(F, a, bg, k ? 63 - s : s); }
#endif
        }
        __syncthreads();
    } SEAM(3);
    if (IN(4)) {
        pg8::Gemm g{(const bf16_t*)(ws + WS_OFOX), (const bf16_t*)(ws + WS_ONSA), (const bf16_t*)(ws + WS_WF), (const bf16_t*)(ws + WS_WN), M, D, 512};
        pg8::StaticOrder S; S.init(M, D, F.G, F.bid, 1);
        pg8::EpiMerge E{(const bf16_t*)(ws + WS_GA), (const bf16_t*)(ws + WS_GB), (bf16_t*)(ws + WS_MERGED)};
        pg8::gemm_phase<pg8::EpiMerge, true, true>(F.lds, g, S, E);
    } SEAM(4);
    if (IN(5)) {
        pg8::Gemm g{(const bf16_t*)(ws + WS_MERGED), nullptr, (const bf16_t*)(ws + WS_WOUT), nullptr, M, D, D};
        pg8::StaticOrder S; S.init(M, D, F.G, F.bid, 0);
        pg8::EpiRes E{a.x, a.out, (bf16_t*)(ws + WS_XN), (float*)(ws + WS_SSQ1)};
        pg8::gemm_phase<pg8::EpiRes, true, true>(F.lds, g, S, E);
    } SEAM(5);
    if (IN(6)) {
        pg8::Gemm g{(const bf16_t*)(ws + WS_XN), nullptr, (const bf16_t*)(ws + WS_W1), nullptr, M, FF, D};
        pg8::StaticOrder S; S.init(M, FF, F.G, F.bid, 0);
        pg8::EpiFF1 E{(const float*)(ws + WS_SSQ1), (bf16_t*)(ws + WS_H)};
        pg8::gemm_phase<pg8::EpiFF1, true, true>(F.lds, g, S, E);
    } SEAM(6);
    if (IN(7)) {
        pg8::Gemm g{(const bf16_t*)(ws + WS_H), nullptr, (const bf16_t*)(ws + WS_W2), nullptr, M, D, FF};
        pg8::StaticOrder S; S.init(M, D, F.G, F.bid, 0);
        pg8::EpiRes E{a.out, a.out, nullptr, (float*)(ws + WS_SSQ2)};
        pg8::gemm_phase<pg8::EpiRes, true, true>(F.lds, g, S, E);
    } SEAM(7);
    if (IN(8)) {
        const int gw = F.bid * NWAVES + F.wave, NGW = F.G * NWAVES;
        const f32x4* gp = (const f32x4*)a.g_final + F.lane; f32x4 gv[4];
#pragma unroll
        for (int j = 0; j < 4; ++j) gv[j] = gp[64 * j];
        for (int m = gw; m < M; m += NGW) {
            const f32x4* sp = (const f32x4*)((const float*)(ws + WS_SSQ2) + (size_t)m * 16); const f32x4 s = (sp[0] + sp[1]) + (sp[2] + sp[3]);
            const float rstd = 1.0f / sqrtf(((s[0] + s[1]) + (s[2] + s[3])) * (1.0f / D) + RMS_EPS);
            f32x4* xr = (f32x4*)(a.out + (size_t)m * D) + F.lane;
#pragma unroll
            for (int j = 0; j < 4; ++j) xr[64 * j] = xr[64 * j] * rstd * gv[j];
        }
    }
#undef IN
#undef SEAM
}

extern "C" void kernel_launch(void* const* d_in, const int* in_sizes, int n_in, void* d_out, int out_size, void* d_ws, size_t ws_size, hipStream_t stream) {
    static int grid = 0;
    if (grid == 0) {
        if (n_in != 18 || in_sizes[0] != M * D || out_size != M * D || ws_size < WS_END) { fprintf(stderr, "kernel_launch: unexpected shapes (n_in %d, in0 %d, out %d, ws %zu)\n", n_in, n_in > 0 ? in_sizes[0] : -1, out_size, ws_size); grid = -1; return; }
        int dev = 0, cus = 0, per_cu = 0;
        if (hipGetDevice(&dev) != hipSuccess || hipDeviceGetAttribute(&cus, hipDeviceAttributeMultiprocessorCount, dev) != hipSuccess) { grid = -1; return; }
        if (hipFuncSetAttribute((const void*)fwd_kernel, hipFuncAttributeMaxDynamicSharedMemorySize, LDS_BYTES) != hipSuccess) { fprintf(stderr, "hipFuncSetAttribute failed\n"); grid = -1; return; }
        if (hipOccupancyMaxActiveBlocksPerMultiprocessor(&per_cu, (const void*)fwd_kernel, NWAVES * 64, LDS_BYTES) != hipSuccess || per_cu < 1) { fprintf(stderr, "occupancy query: %d blocks/CU\n", per_cu); grid = -1; (void)hipGetLastError(); return; }
        grid = cus;
    }
    if (grid < 0) return;
    (void)hipMemsetAsync((char*)d_ws + WS_CTL, 0, CTL_ZERO_BYTES, stream);
    Args a{};
    const float** p = (const float**)&a;
    for (int i = 0; i < 18; ++i) p[i] = (const float*)d_in[i];
    a.out = (float*)d_out; a.ws = (unsigned char*)d_ws;
    constexpr int NPH = 9;
#ifdef PROBE_PH
    const int cuts[3] = {0, PROBE_PH + 1, NPH}; const int los[2] = {0, PROBE_PH}; const int nl = 2;
#elif defined(PROBE_SPLIT)
    const int cuts[3] = {0, PROBE_SPLIT, NPH}; const int los[2] = {0, PROBE_SPLIT}; const int nl = 2;
#else
    const int cuts[3] = {0, NPH, NPH}; const int los[2] = {0, 0}; const int nl = 1;
#endif
    for (int li = 0; li < nl; ++li) {
        a.ph_lo = los[li]; a.ph_hi = cuts[li + 1]; a.li = li;
        void* args[] = {&a};
        hipError_t e = hipLaunchCooperativeKernel((void*)fwd_kernel, dim3(grid), dim3(NWAVES * 64), args, LDS_BYTES, stream);
        if (e != hipSuccess) { fprintf(stderr, "cooperative launch failed: %s (grid %d)\n", hipGetErrorString(e), grid); break; }
    }
}
```
